# Optimizing an MI355X kernel written in HIP

```python
import jax, jax.numpy as jnp
from jax import lax
import numpy as np

D_MODEL = 2048
BATCH = 2
SEQ = 4096
DEPTH = 4
DEC_BATCH = 32
DEC_SEQ = 64
PAST_LEN = 2048

CHUNK = 64
N_EVEN = (DEPTH + 1) // 2
N_ODD = DEPTH // 2
H_RET = 4
DK_RET = 256
DV_RET = 256
QK_RET = H_RET * DK_RET
RET_W = H_RET * DV_RET
H_FOX = 8
DH_FOX = 128
FOX_W = H_FOX * DH_FOX
MIX_W = RET_W + FOX_W
IN_SPLITS = (QK_RET, QK_RET, RET_W, RET_W, FOX_W, FOX_W, FOX_W, H_FOX)
IN_W = sum(IN_SPLITS)
POOL_WINDOWS = (2, 4, 8, 16)
N_POOL_GROUPS = len(POOL_WINDOWS)
POOL_GC = D_MODEL // N_POOL_GROUPS
POOL_BUF = max(POOL_WINDOWS) - 1
D_FF = -(-8 * D_MODEL // (3 * 256)) * 256
PLE_DIM = 256
Q_BLOCK = 128
ROPE_BASE = 10000.0
EPS = 1e-6
NEG_INF = -1e30
FORGET_BIAS = 2.0

kernel_name = 'chunk_causal_retention_fox_pool_encoder_step'


def rmsnorm(x, g):
    xf = x.astype(jnp.float32)
    y = xf * lax.rsqrt(jnp.mean(xf * xf, axis=-1, keepdims=True) + EPS)
    return (y * g.astype(jnp.float32)).astype(x.dtype)


def head_rmsnorm(x):
    xf = x.astype(jnp.float32)
    return xf * lax.rsqrt(jnp.mean(xf * xf, axis=-1, keepdims=True) + EPS)


def rope(x, pos):
    half = x.shape[-1] // 2
    inv = ROPE_BASE ** (-jnp.arange(half, dtype=jnp.float32) / half)
    ang = pos.astype(jnp.float32)[:, None] * inv[None, :]
    cos = jnp.cos(ang)[None, :, None, :]
    sin = jnp.sin(ang)[None, :, None, :]
    xf = x.astype(jnp.float32)
    x1, x2 = xf[..., :half], xf[..., half:]
    return jnp.concatenate([x1 * cos - x2 * sin, x1 * sin + x2 * cos], axis=-1).astype(x.dtype)


def retention_chunkwise(q, k, v, state):
    B, T, H, dk = q.shape
    L = min(T, CHUNK)
    n = T // L
    log_g = jnp.log1p(-jnp.power(2.0, -5.0 - jnp.arange(H, dtype=jnp.float32)))
    idx = jnp.arange(L, dtype=jnp.float32)
    intra = jnp.exp(log_g[:, None, None] * jnp.abs(idx[:, None] - idx[None, :]))
    q_dec = jnp.exp(log_g[None, :] * (idx[:, None] + 1.0))
    k_dec = jnp.exp(log_g[None, :] * (L - 1.0 - idx[:, None]))
    s_dec = jnp.exp(log_g * L)
    scale = dk ** -0.5

    def to_chunks(a):
        return jnp.moveaxis(a.astype(jnp.float32).reshape(B, n, L, H, a.shape[-1]), 1, 0)

    def step(S, qkv):
        qc, kc, vc = qkv
        kc = kc * scale
        sc = jnp.einsum('bihd,bjhd->bhij', qc, kc) * intra[None]
        o = (jnp.einsum('bhij,bjhe->bihe', sc, vc)
             + jnp.einsum('bihd,bhde->bihe', qc, S) * q_dec[None, :, :, None])
        S = S * s_dec[None, :, None, None] + jnp.einsum('bjhd,bjhe->bhde', kc * k_dec[None, :, :, None], vc)
        return S, o

    S, o = lax.scan(step, state.astype(jnp.float32), (to_chunks(q), to_chunks(k), to_chunks(v)))
    o = jnp.moveaxis(o, 0, 1).reshape(B, T, H, v.shape[-1])
    return o, S


def forgetting_attention(q, k_all, v_all, logf_all, q_off):
    B, Tq, H, d = q.shape
    Tk = k_all.shape[1]
    c_k = jnp.transpose(jnp.cumsum(logf_all.astype(jnp.float32), axis=1), (0, 2, 1))
    qb = min(Tq, Q_BLOCK)
    nb = Tq // qb
    k_pos = jnp.arange(Tk)
    scale = d ** -0.5

    def block(bi):
        start = bi * qb
        q_blk = lax.dynamic_slice_in_dim(q, start, qb, axis=1)
        q_abs = q_off + start + jnp.arange(qb)
        c_q = lax.dynamic_slice_in_dim(c_k, q_off + start, qb, axis=2)
        s = (jnp.einsum('bqhd,bkhd->bhqk', q_blk, k_all).astype(jnp.float32) * scale
             + (c_q[..., None] - c_k[:, :, None, :]))
        s = jnp.where(k_pos[None, :] <= q_abs[:, None], s, NEG_INF)
        p = jax.nn.softmax(s, axis=-1)
        return jnp.einsum('bhqk,bkhd->bqhd', p.astype(v_all.dtype), v_all)

    out = lax.map(block, jnp.arange(nb))
    return jnp.moveaxis(out, 0, 1).reshape(B, Tq, H, d)


def pool_mixer(u, buf, pos0, w_pool, pool_scale):
    B, T, D = u.shape
    full = jnp.concatenate([buf.astype(u.dtype), u], axis=1)
    cs = jnp.pad(jnp.cumsum(full.astype(jnp.float32), axis=1), ((0, 0), (1, 0), (0, 0)))
    pos = pos0 + jnp.arange(T)
    outs = []
    for g, w in enumerate(POOL_WINDOWS):
        sl = slice(g * POOL_GC, (g + 1) * POOL_GC)
        hi = cs[:, POOL_BUF + 1:POOL_BUF + 1 + T, sl]
        lo = cs[:, POOL_BUF + 1 - w:POOL_BUF + 1 - w + T, sl]
        cnt = jnp.minimum(w, pos + 1).astype(jnp.float32)
        outs.append((hi - lo) / cnt[None, :, None])
    pooled = jnp.stack(outs, axis=2)
    diff = (pooled - u.astype(jnp.float32).reshape(B, T, N_POOL_GROUPS, POOL_GC)).astype(u.dtype)
    y = jnp.einsum('btgc,gcd->btgd', diff, w_pool).reshape(B, T, D) * pool_scale
    return y, full[:, -POOL_BUF:]


def swiglu(h, w_gate, w_up, w_down):
    return (jax.nn.silu(h @ w_gate) * (h @ w_up)) @ w_down


def run_trunk(x, p, st_ret, c_k, c_v, c_lf, st_pool, pos0, norm_mix, w_in, b_forget, w_out,
              w_pool, pool_scale, norm_ffn, w_gate, w_up, w_down, norm_ple, ple_gate, ple_proj, final_norm):
    B, T, _ = x.shape
    past = c_k.shape[2]
    pos = pos0 + jnp.arange(T, dtype=jnp.int32)
    split_at = [int(s) for s in np.cumsum(IN_SPLITS)[:-1]]
    new_ret, new_k, new_v, new_lf, new_pool = [], [], [], [], []
    for i in range(DEPTH):
        h = rmsnorm(x, norm_mix[i])
        if i % 2 == 0:
            e = i // 2
            q_r, k_r, v_r, g_r, q_f, k_f, v_f, f_r = jnp.split(h @ w_in[e], split_at, axis=-1)
            q_r = rope(q_r.reshape(B, T, H_RET, DK_RET), pos)
            k_r = rope(k_r.reshape(B, T, H_RET, DK_RET), pos)
            o_r, s_new = retention_chunkwise(q_r, k_r, v_r.reshape(B, T, H_RET, DV_RET), st_ret[e])
            o_r = head_rmsnorm(o_r).astype(x.dtype).reshape(B, T, RET_W) * jax.nn.silu(g_r)
            q_f = q_f.reshape(B, T, H_FOX, DH_FOX)
            k_f = k_f.reshape(B, T, H_FOX, DH_FOX)
            v_f = v_f.reshape(B, T, H_FOX, DH_FOX)
            lf = jax.nn.log_sigmoid(f_r.astype(jnp.float32) + b_forget[e].astype(jnp.float32))
            o_f = forgetting_attention(
                q_f,
                jnp.concatenate([c_k[e].astype(k_f.dtype), k_f], axis=1),
                jnp.concatenate([c_v[e].astype(v_f.dtype), v_f], axis=1),
                jnp.concatenate([c_lf[e].astype(jnp.float32), lf], axis=1),
                past)
            mix = jnp.concatenate([o_r, o_f.reshape(B, T, FOX_W)], axis=-1) @ w_out[e]
            new_ret.append(s_new.astype(st_ret.dtype))
            new_k.append(k_f)
            new_v.append(v_f)
            new_lf.append(lf)
        else:
            o = i // 2
            mix, buf = pool_mixer(h, st_pool[o], pos0, w_pool[o], pool_scale[o])
            new_pool.append(buf)
        x = x + mix
        x = x + swiglu(rmsnorm(x, norm_ffn[i]), w_gate[i], w_up[i], w_down[i])
        gate = jax.nn.sigmoid(rmsnorm(x, norm_ple[i]) @ ple_gate[i])
        x = x + gate * (p[i] @ ple_proj[i])
    return (rmsnorm(x, final_norm), jnp.stack(new_ret), jnp.stack(new_k), jnp.stack(new_v),
            jnp.stack(new_lf), jnp.stack(new_pool))


def setup_inputs(seed: int = 0) -> dict:
    key = jax.random.key(seed)
    ks = jax.random.split(key, 26)

    def nrm(k, shape, scale):
        return jax.random.normal(k, shape, jnp.float32) * scale

    return {
        'x_prompt': nrm(ks[0], (BATCH, SEQ, D_MODEL), 1.0),
        'x_sample': nrm(ks[1], (DEC_BATCH, DEC_SEQ, D_MODEL), 1.0),
        'p_prompt': nrm(ks[2], (DEPTH, BATCH, SEQ, PLE_DIM), 1.0),
        'p_sample': nrm(ks[3], (DEPTH, DEC_BATCH, DEC_SEQ, PLE_DIM), 1.0),
        'state_ret': nrm(ks[4], (N_EVEN, DEC_BATCH, H_RET, DK_RET, DV_RET), 0.1),
        'cache_fox_k': nrm(ks[5], (N_EVEN, DEC_BATCH, PAST_LEN, H_FOX, DH_FOX), 1.0),
        'cache_fox_v': nrm(ks[6], (N_EVEN, DEC_BATCH, PAST_LEN, H_FOX, DH_FOX), 1.0),
        'cache_fox_logf': jax.nn.log_sigmoid(FORGET_BIAS + nrm(ks[7], (N_EVEN, DEC_BATCH, PAST_LEN, H_FOX), 1.0)),
        'state_pool': nrm(ks[8], (N_ODD, DEC_BATCH, POOL_BUF, D_MODEL), 1.0),
        'norm_mix': 1.0 + nrm(ks[9], (DEPTH, D_MODEL), 0.02),
        'w_in': nrm(ks[10], (N_EVEN, D_MODEL, IN_W), D_MODEL ** -0.5),
        'b_forget': FORGET_BIAS + nrm(ks[11], (N_EVEN, H_FOX), 0.1),
        'w_out': nrm(ks[12], (N_EVEN, MIX_W, D_MODEL), MIX_W ** -0.5),
        'w_pool': nrm(ks[13], (N_ODD, N_POOL_GROUPS, POOL_GC, POOL_GC), POOL_GC ** -0.5),
        'pool_scale': 1.0 + nrm(ks[14], (N_ODD, D_MODEL), 0.1),
        'norm_ffn': 1.0 + nrm(ks[15], (DEPTH, D_MODEL), 0.02),
        'w_gate': nrm(ks[16], (DEPTH, D_MODEL, D_FF), D_MODEL ** -0.5),
        'w_up': nrm(ks[17], (DEPTH, D_MODEL, D_FF), D_MODEL ** -0.5),
        'w_down': nrm(ks[18], (DEPTH, D_FF, D_MODEL), D_FF ** -0.5),
        'norm_ple': 1.0 + nrm(ks[19], (DEPTH, D_MODEL), 0.02),
        'ple_gate': nrm(ks[20], (DEPTH, D_MODEL, D_MODEL), D_MODEL ** -0.5),
        'ple_proj': nrm(ks[21], (DEPTH, PLE_DIM, D_MODEL), PLE_DIM ** -0.5),
        'final_norm': 1.0 + nrm(ks[22], (D_MODEL,), 0.02),
    }


def reference(x_prompt, x_sample, p_prompt, p_sample, state_ret, cache_fox_k, cache_fox_v, cache_fox_logf,
              state_pool, norm_mix, w_in, b_forget, w_out, w_pool, pool_scale, norm_ffn, w_gate, w_up, w_down,
              norm_ple, ple_gate, ple_proj, final_norm):
    B = x_prompt.shape[0]
    dt = x_prompt.dtype
    empty_kv = jnp.zeros((N_EVEN, B, 0, H_FOX, DH_FOX), dt)
    empty_lf = jnp.zeros((N_EVEN, B, 0, H_FOX), jnp.float32)
    zero_ret = jnp.zeros((N_EVEN, B, H_RET, DK_RET, DV_RET), jnp.float32)
    zero_pool = jnp.zeros((N_ODD, B, POOL_BUF, D_MODEL), dt)
    y_prompt, ret_p, k_p, v_p, lf_p, pool_p = run_trunk(
        x_prompt, p_prompt, zero_ret, empty_kv, empty_kv, empty_lf, zero_pool, 0,
        norm_mix, w_in, b_forget, w_out, w_pool, pool_scale, norm_ffn, w_gate, w_up, w_down,
        norm_ple, ple_gate, ple_proj, final_norm)
    y_sample, ret_s, k_s, v_s, lf_s, pool_s = run_trunk(
        x_sample, p_sample, state_ret, cache_fox_k, cache_fox_v, cache_fox_logf, state_pool, cache_fox_k.shape[2],
        norm_mix, w_in, b_forget, w_out, w_pool, pool_scale, norm_ffn, w_gate, w_up, w_down,
        norm_ple, ple_gate, ple_proj, final_norm)
    return (y_prompt, y_sample, ret_p, ret_s, k_p, k_s, v_p, v_s, lf_p, lf_s, pool_p, pool_s)
```

```cpp
#include <hip/hip_runtime.h>
#include <cstdio>
#include <cstdint>

#ifndef MK_MULTI
#define MK_MULTI 0
#endif

#define LAS __attribute__((address_space(3)))
#define GAS __attribute__((address_space(1)))
#define DI __device__ __forceinline__
typedef unsigned short bf16_t;
typedef short bf16x8 __attribute__((ext_vector_type(8)));
typedef short s16x4 __attribute__((ext_vector_type(4)));
typedef float f32x2 __attribute__((ext_vector_type(2)));
typedef float f32x4 __attribute__((ext_vector_type(4)));
typedef float f32x16 __attribute__((ext_vector_type(16)));
typedef unsigned u32x2 __attribute__((ext_vector_type(2)));
typedef unsigned u32x4 __attribute__((ext_vector_type(4)));

constexpr int DM = 2048, NB_P = 2, SEQ = 4096, DEPTH = 4, NB_S = 32, SSEQ = 64, PAST = 2048;
constexpr int MP = NB_P * SEQ, MS = NB_S * SSEQ, M = MP + MS;
constexpr int NEVEN = 2, NODD = 2, HR = 4, DKR = 256, HF = 8, DHF = 128, RW = 1024, FW = 1024, MIXW = 2048;
constexpr int INW = 7176, INW_P = 7168, DFF = 5632, PLE = 256, PBUF = 15;
#ifndef LDF_PAD
#define LDF_PAD 64
#endif
constexpr int LDF = DFF + LDF_PAD;
constexpr float EPS = 1e-6f;
constexpr int NBLK = 256, NTHR = 512;

constexpr size_t O_YP = 0, O_YS = O_YP + (size_t)MP * DM, O_RSP = O_YS + (size_t)MS * DM, O_RSS = O_RSP + (size_t)NEVEN * NB_P * HR * 65536,
                 O_KP = O_RSS + (size_t)NEVEN * NB_S * HR * 65536, O_KS = O_KP + (size_t)NEVEN * MP * FW, O_VP = O_KS + (size_t)NEVEN * MS * FW,
                 O_VS = O_VP + (size_t)NEVEN * MP * FW, O_LP = O_VS + (size_t)NEVEN * MS * FW, O_LS = O_LP + (size_t)NEVEN * MP * HF,
                 O_PP = O_LS + (size_t)NEVEN * MS * HF, O_PS = O_PP + (size_t)NODD * NB_P * PBUF * DM, O_END = O_PS + (size_t)NODD * NB_S * PBUF * DM;

constexpr size_t al256(size_t x) { return (x + 255) & ~(size_t)255; }
constexpr size_t WS_CTL = 0, CTL_BYTES = 1u << 20;
constexpr size_t WS_SS = WS_CTL + CTL_BYTES, SS_BYTES = 2u << 20;
constexpr size_t ZERO_BYTES = CTL_BYTES + SS_BYTES;
constexpr size_t WS_ROPE = WS_SS + SS_BYTES;
constexpr size_t WS_GWF = WS_ROPE + (size_t)4096 * 128 * 8;
constexpr size_t WS_WIN = al256(WS_GWF + (size_t)2 * 2048 * 8 * 4);
constexpr size_t WS_WOUT = WS_WIN + (size_t)2 * INW_P * DM * 2;
constexpr size_t WS_WGU = WS_WOUT + (size_t)2 * DM * MIXW * 2;
constexpr size_t WS_WDN = WS_WGU + (size_t)4 * 2 * DFF * DM * 2;
constexpr size_t WS_WPG = WS_WDN + (size_t)4 * DM * LDF * 2;
constexpr size_t WS_WPP = WS_WPG + (size_t)4 * DM * DM * 2;
constexpr size_t WS_WPL = WS_WPP + (size_t)4 * DM * PLE * 2;
constexpr size_t WS_PB = WS_WPL + (size_t)2 * DM * 512 * 2;
constexpr size_t WS_PPJ = WS_PB + (size_t)4 * M * PLE * 2;
constexpr size_t WS_XRES = WS_PPJ + (size_t)4 * M * DM * 2;
constexpr size_t WS_XB0 = WS_XRES + (size_t)M * DM * 4;
constexpr size_t WS_XB1 = WS_XB0 + (size_t)M * DM * 2;
constexpr size_t WS_MIXA = WS_XB1 + (size_t)M * DM * 2;
constexpr size_t WS_ACT = WS_MIXA + (size_t)M * DM * 2;
constexpr size_t WS_QR = WS_ACT + (size_t)M * LDF * 2;
constexpr size_t SZ_R = (size_t)M * RW * 2;
constexpr size_t WS_QD = WS_QR + SZ_R, WS_KR = WS_QD + SZ_R, WS_KD = WS_KR + SZ_R, WS_VR = WS_KD + SZ_R, WS_GR = WS_VR + SZ_R;
constexpr size_t WS_QF = WS_GR + SZ_R;
constexpr size_t SZ_F = (size_t)MP * FW * 2;
constexpr size_t WS_KF = WS_QF + SZ_F, WS_VF = WS_KF + SZ_F;
constexpr size_t WS_QS32 = WS_VF + SZ_F;
constexpr size_t WS_SPREV = WS_QS32 + (size_t)(MS + 256) * FW * 4;
constexpr size_t WS_XDUM = WS_SPREV + (size_t)8 * 64 * 65536 * 2;
constexpr size_t WS_XBDUM = WS_XDUM + (size_t)M * DM * 4;
constexpr size_t WS_SLAB = WS_XBDUM + (size_t)M * DM * 2;
constexpr size_t WS_END = WS_SLAB + (size_t)64 * 4 * 65536 * 4;

constexpr int CW_BAR = 4096;
constexpr int CW_DEP = 16384;
constexpr int CW_Q = 8192;

constexpr int LDS_MAIN = 131072;
constexpr int LDS_MISC = LDS_MAIN;
constexpr int LDS_BYTES = LDS_MAIN + 256;

#define VM_WAIT() asm volatile("s_waitcnt vmcnt(0)" ::: "memory")
#define LDS_WAIT() asm volatile("s_waitcnt lgkmcnt(0)" ::: "memory")
#define LDS_BARRIER() do { asm volatile("s_waitcnt lgkmcnt(0)" ::: "memory"); __builtin_amdgcn_s_barrier(); asm volatile("" ::: "memory"); } while (0)
DI unsigned cvt_pk_bf16(float lo, float hi) { unsigned r; asm volatile("v_cvt_pk_bf16_f32 %0, %1, %2" : "=v"(r) : "v"(lo), "v"(hi)); return r; }
DI int opaque_tid() { int t = threadIdx.x; asm volatile("" : "+v"(t)); return t; }
DI int launder_i(int v) { asm volatile("" : "+s"(v)); return v; }
typedef unsigned long long u64;
DI u64 ss_fix(float s) { return (u64)(s * 16777216.0f); }
DI float ss_val(u64 v) { return (float)v * (1.0f / 16777216.0f); }
DI bf16_t f2bf(float f) { unsigned u = __float_as_uint(f); u += 0x7fffu + ((u >> 16) & 1u); return (bf16_t)(u >> 16); }
DI float bf2f(unsigned short b) { return __uint_as_float(((unsigned)b) << 16); }
DI float shfl_xor_f(float v, int m) { const int l = (opaque_tid() & 63) ^ m; return __int_as_float(__builtin_amdgcn_ds_bpermute(l << 2, __float_as_int(v))); }
DI double shfl_up_d(double v, int o) { int l = (opaque_tid() & 63) - o; l = l < 0 ? l + o : l; const long long b = __double_as_longlong(v);
    const int lo = __builtin_amdgcn_ds_bpermute(l << 2, (int)(b & 0xffffffffll)), hi = __builtin_amdgcn_ds_bpermute(l << 2, (int)(b >> 32));
    return __longlong_as_double(((long long)hi << 32) | (unsigned)lo); }
DI float wave_sum(float v) {
#pragma unroll
    for (int o = 1; o < 64; o <<= 1) v += shfl_xor_f(v, o);
    return v;
}
DI int row_pos(int m) { return m < MP ? (m & (SEQ - 1)) : PAST + ((m - MP) & (SSEQ - 1)); }

#define XB_TMO      128
#define XB_XCNT(j)  (256  + 64 * (j))
#define XB_XSUB(j)  (1280 + 64 * (j))
#define XB_XGEN(j)  (2304 + 64 * (j))
#define XB_TOP      3328
#define XB_TOPGEN   3392
#define XCD_BAR_WORDS 3456
#define XB_SPIN_CAP (1u << 18)

__device__ __forceinline__ unsigned xb_ld(unsigned* p)              { return __hip_atomic_load(p, __ATOMIC_RELAXED, __HIP_MEMORY_SCOPE_AGENT); }
__device__ __forceinline__ unsigned xb_add(unsigned* p, unsigned v) { return __hip_atomic_fetch_add(p, v, __ATOMIC_RELAXED, __HIP_MEMORY_SCOPE_AGENT); }
__device__ __forceinline__ unsigned xb_xcc_id() { return (unsigned)__builtin_amdgcn_s_getreg((3 << 11) | 20) & 0xFu; }
#define XB_SPIN(cond, bar) do { unsigned _sp = 0; while (cond) { __builtin_amdgcn_s_sleep(1); \
    if ((++_sp & 255u) == 0u) { if (xb_ld(&(bar)[XB_TMO])) break; if (_sp > XB_SPIN_CAP) { atomicAdd(&(bar)[XB_TMO], 1u); break; } } } } while (0)

struct XcdBarrier {
    unsigned* bar; unsigned x;
    volatile LAS unsigned* st;
};

__device__ __forceinline__ XcdBarrier xcd_barrier_post(unsigned* bar, volatile LAS unsigned* st) {
    XcdBarrier b; b.bar = bar; b.x = xb_xcc_id(); b.st = st;
    if (threadIdx.x == 0) (void)xb_add(&bar[XB_XCNT(b.x)], 1u);
    return b;
}
__device__ __forceinline__ void xcd_barrier_complete(unsigned* bar, unsigned x, unsigned& nloc, unsigned& nx) {
    const unsigned G = gridDim.x * gridDim.y * gridDim.z;
    unsigned sum, cnt, mine, sp = 0u;
    for (;;) {
        sum = 0u; cnt = 0u; mine = 0u;
#pragma unroll
        for (unsigned j = 0; j < 16; ++j) { const unsigned c = xb_ld(&bar[XB_XCNT(j)]); sum += c; cnt += (c > 0u) ? 1u : 0u; mine = (j == x) ? c : mine; }
        if (sum == G) break;
        __builtin_amdgcn_s_sleep(1);
        if ((++sp & 255u) == 0u) { if (xb_ld(&bar[XB_TMO])) break; if (sp > XB_SPIN_CAP) { atomicAdd(&bar[XB_TMO], 1u); break; } }
    }
    nloc = mine > 0u ? mine : 1u; nx = cnt > 0u ? cnt : 1u;
}

__device__ __forceinline__ void xcd_barrier(const XcdBarrier& b) {
    asm volatile("s_waitcnt vmcnt(0)" ::: "memory");
    __syncthreads();
    if (threadIdx.x == 0) {
        unsigned* bar = b.bar;
        __builtin_amdgcn_s_waitcnt(0);
        unsigned nloc = b.st[0], nx = b.st[1];
        if (nloc == 0u) { xcd_barrier_complete(bar, b.x, nloc, nx); b.st[0] = nloc; b.st[1] = nx; }
        const unsigned old = xb_add(&bar[XB_XSUB(b.x)], 1u);
        const unsigned gen = old / nloc;
        if (old + 1u == (gen + 1u) * nloc) {
            __builtin_amdgcn_fence(__ATOMIC_RELEASE, "agent");
            asm volatile("s_waitcnt vmcnt(0)" ::: "memory");
            const unsigned og = xb_add(&bar[XB_TOP], 1u);
            const unsigned tg = og / nx;
            if (og + 1u == (tg + 1u) * nx) xb_add(&bar[XB_TOPGEN], 1u);
            else XB_SPIN(xb_ld(&bar[XB_TOPGEN]) == tg, bar);
            __builtin_amdgcn_fence(__ATOMIC_ACQUIRE, "agent");
            xb_add(&bar[XB_XGEN(b.x)], 1u);
            asm volatile("s_waitcnt vmcnt(0)" ::: "memory");
        } else {
            XB_SPIN(xb_ld(&bar[XB_XGEN(b.x)]) == gen, bar);
            __builtin_amdgcn_fence(__ATOMIC_ACQUIRE, "agent");
            asm volatile("s_waitcnt vmcnt(0)" ::: "memory");
        }
    }
    __syncthreads();
}
#ifndef STAGGER
#define STAGGER 1
#endif
#ifndef PG8_WGM
#define PG8_WGM 4
#endif
namespace pg8 {
#define PG8_LAS __attribute__((address_space(3)))
constexpr int BM = 256, BK = 64, HALF = 128, HTB = HALF * BK * 2  , STAGE_BYTES = 8 * HTB, NXCD = 8, WGM = PG8_WGM;

#ifndef LINE128
#define LINE128 1
#endif
#if LINE128
__host__ __device__ __forceinline__ int lds_g(int r) { return ((r >> 1) & 3) | (((r >> 3) & 1) << 2); }
__host__ __device__ __forceinline__ int lds_byte(int r, int c) { return (r >> 3) * 1024 + (r & 7) * 128 + ((((c >> 3) ^ lds_g(r)) & 7) << 4) + (c & 7) * 2; }
__host__ __device__ __forceinline__ void stage_rc(int b, int& R, int& C) { const int s_ = b / 1024, sb = b % 1024; R = s_ * 8 + sb / 128; C = ((((sb % 128) / 16) ^ lds_g(R)) & 7) * 8; }
#else
__host__ __device__ __forceinline__ int lds_byte(int r, int c) { const int st = (r >> 4) * 2 + (c >> 5), rr = r & 15, cc = c & 31, ob = rr * 64 + cc * 2; return st * 1024 + (ob ^ (((ob >> 9) & 1) << 5)); }
__host__ __device__ __forceinline__ void stage_rc(int b, int& R, int& C) { const int st = b / 1024, sb = b % 1024, swz = sb ^ (((sb >> 9) & 1) << 5); R = (st >> 1) * 16 + swz / 64; C = (st & 1) * 32 + (swz % 64) / 2; }
#endif
__host__ __device__ __forceinline__ int perm32(int rho) { const int n = rho >> 4, i = rho & 15; return 8 * (i >> 2) + 4 * n + (i & 3); }

template <int V> struct IC { static constexpr int v = V; };
struct Unit { int pm, pn, k0, nt, kq, li; };
struct Gemm { int lda, ldb, K; };

struct StaticOrder {
    int nM, nN, nwg, G, c;
    const bf16_t* A; const bf16_t* Bt; int lda, ldb;
    int a_kgrp;
    int a_kgrp_div;
    int b_mgrp;
    int b_mrows;
    int ntk;
    int rot;
    int split;
    int nomma;
    __device__ void init(int M_, int N_, int G_, int c_, const bf16_t* A_, const bf16_t* Bt_, int lda_, int ldb_, int K_) {
        nM = M_ / BM; nN = N_ / BM; nwg = nM * nN; G = G_; c = c_; A = A_; Bt = Bt_; lda = lda_; ldb = ldb_; a_kgrp = 0; a_kgrp_div = 1; b_mgrp = 0; b_mrows = 0; ntk = K_ / BK; split = 0; rot = 0; nomma = 0; }
    __device__ void tile_of(int L, Unit& u) const {
        int wgid = L; { const int q = nwg / NXCD, r = nwg % NXCD, xcd = wgid % NXCD; int off = wgid / NXCD;
            if (rot && r == 0) { off += xcd * rot; off -= (off >= q) ? q : 0; }
            wgid = (xcd < r ? xcd * (q + 1) : r * (q + 1) + (xcd - r) * q) + off; }
        const int nig = WGM * nN, gid = wgid / nig, fm = gid * WGM, gsz = (nM - fm) < WGM ? (nM - fm) : WGM;
        u.pm = fm + ((wgid % nig) % gsz); u.pn = (wgid % nig) / gsz;
    }
    __device__ int nfull() const { return split ? (nwg / G) * G : nwg; }
    __device__ bool next(int i, Unit& u) const {
        const int nf = nfull(), q4 = ntk / 4, ip = nwg / G;
        const int li = (split == 2) ? 8 * (c >> 5) + (c & 7) : c >> 2;
        const int kqv = (split == 2) ? (c >> 3) & 3 : c & 3;
        if (split == 1 && STAGGER && (c & 1)) i = (i == 0) ? ip : (i == ip) ? 0 : i;
        const long L = (long)i * G + c;
        const bool full = L < nf;
        const bool part = !full && split && i == nwg / G && li < nwg - nf;
        if (!full && !part) return false;
        Unit t; tile_of(full ? (int)L : nf + li, t);
        const bool wholeK = full || split == 2;
        t.kq = full ? -1 : kqv; t.nt = wholeK ? ntk : q4; t.k0 = wholeK ? 0 : kqv * q4 * BK; t.li = full ? 0 : li;
        u = t; return true;
    }
    __device__ __forceinline__ const char* aptr(const Unit& u) const { return (const char*)(A + (size_t)u.pm * BM * lda + (a_kgrp ? (size_t)(u.pn / a_kgrp_div) * a_kgrp : (size_t)0) + u.k0); }
    __device__ __forceinline__ const char* bptr(const Unit& u) const { return (const char*)(Bt + ((size_t)u.pn * BM + (b_mgrp ? (size_t)(u.pm / b_mgrp) * b_mrows : (size_t)0)) * ldb + u.k0); }
    __device__ __forceinline__ void a_ready(const Unit&) const {}
    __device__ __forceinline__ void done(const Unit&) const {}
};


#ifndef PG8_ALIGN
#define PG8_ALIGN true
#endif
template <class Epi, class Sched, bool ALIGN_EPI = PG8_ALIGN, bool QT = false>
__device__ __forceinline__ void gemm_phase(PG8_LAS unsigned char* lds, const Gemm g, const Sched& S, const Epi& E) {
    const int tid = opaque_tid(), wid = __builtin_amdgcn_readfirstlane(tid >> 6), lane = tid & 63, wr = wid >> 2, wc = wid & 3, fr = lane & 15, fq = lane >> 4;
    unsigned voffA[2], voffB[2];
#pragma unroll
    for (int i = 0; i < 2; ++i) { int R, C; stage_rc(tid * 16 + i * 8192, R, C);
        voffA[i] = (unsigned)(R * g.lda + C) * 2u; voffB[i] = (unsigned)(R * g.ldb + C) * 2u; }
    const size_t kstep = (size_t)(BK * 2);
    const size_t hstepA = (size_t)HALF * g.lda * 2, hstepB = (size_t)HALF * g.ldb * 2;
    const unsigned ldsw = (unsigned)wid * 1024u;
    const int aoff = lds_byte(wr * 64 + fr, fq * 8), boff = lds_byte(wc * 32 + fr, fq * 8);
#if LINE128
    const int aoff1 = lds_byte(wr * 64 + fr, fq * 8 + 32), boff1 = lds_byte(wc * 32 + fr, fq * 8 + 32);
#endif
#define PG8_SA(b, h) (((b) * 2 + (h)) * HTB)
#define PG8_SB(b, h) ((4 + (b) * 2 + (h)) * HTB)
#define PG8_STAGE(bufoff, gbase, voff) do { _Pragma("unroll") for (int _i = 0; _i < 2; ++_i) \
        __builtin_amdgcn_global_load_lds((const unsigned*)((const char*)(gbase) + (voff)[_i]), (PG8_LAS unsigned*)(lds + (bufoff) + ldsw + _i * 8192), 16, 0, 0); } while (0)
#if LINE128
#define PG8_LDA1(dst, b, h, m, k) dst[m][k] = *(const PG8_LAS bf16x8*)(lds + PG8_SA(b, h) + ((k) ? aoff1 : aoff) + (m) * 2048)
#define PG8_LDB1(dst, b, h, n, k) dst[n][k] = *(const PG8_LAS bf16x8*)(lds + PG8_SB(b, h) + ((k) ? boff1 : boff) + (n) * 2048)
#else
#define PG8_LDA1(dst, b, h, m, k) dst[m][k] = *(const PG8_LAS bf16x8*)(lds + PG8_SA(b, h) + aoff + (m) * 2048 + (k) * 1024)
#define PG8_LDB1(dst, b, h, n, k) dst[n][k] = *(const PG8_LAS bf16x8*)(lds + PG8_SB(b, h) + boff + (n) * 2048 + (k) * 1024)
#endif
#define PG8_LDA(dst, b, h) do { PG8_LDA1(dst, b, h, 0, 0); PG8_LDA1(dst, b, h, 0, 1); PG8_LDA1(dst, b, h, 1, 0); PG8_LDA1(dst, b, h, 1, 1); PG8_LDA1(dst, b, h, 2, 0); PG8_LDA1(dst, b, h, 2, 1); PG8_LDA1(dst, b, h, 3, 0); PG8_LDA1(dst, b, h, 3, 1); } while (0)
#define PG8_LDB(dst, b, h) do { PG8_LDB1(dst, b, h, 0, 0); PG8_LDB1(dst, b, h, 0, 1); PG8_LDB1(dst, b, h, 1, 0); PG8_LDB1(dst, b, h, 1, 1); } while (0)
#define PG8_MMA(ai, bj, At, Bt) do { __builtin_amdgcn_s_setprio(1); _Pragma("unroll") for (int m = 0; m < 4; ++m) _Pragma("unroll") for (int n = 0; n < 2; ++n) _Pragma("unroll") for (int k = 0; k < 2; ++k) \
        acc[ai][bj][m][n] = __builtin_amdgcn_mfma_f32_16x16x32_bf16(Bt[n][k], At[m][k], acc[ai][bj][m][n], 0, 0, 0); __builtin_amdgcn_s_setprio(0); } while (0)
#define PG8_WAIT_V(n) asm volatile("s_waitcnt vmcnt(" #n ")" ::: "memory")
#define PG8_WAIT_L(n) asm volatile("s_waitcnt lgkmcnt(" #n ")" ::: "memory")
#define PG8_BAR __builtin_amdgcn_s_barrier()
#define PG8_SCHED __builtin_amdgcn_sched_barrier(0)
    Unit cur, nxt; int ui = 0;
    if (!S.next(0, cur)) return;
    f32x4 acc[2][2][4][2];
#pragma unroll
    for (int a = 0; a < 2; ++a)
#pragma unroll
        for (int b = 0; b < 2; ++b)
#pragma unroll
            for (int m = 0; m < 4; ++m)
#pragma unroll
                for (int n = 0; n < 2; ++n) acc[a][b][m][n] = (f32x4){0.f, 0.f, 0.f, 0.f};
    bf16x8 At[4][2], B0[2][2], B1[2][2];
    const char* cA = S.aptr(cur); const char* cB = S.bptr(cur);
    S.a_ready(cur);
    PG8_STAGE(PG8_SB(0, 0), cB, voffB); PG8_STAGE(PG8_SB(0, 1), cB + hstepB, voffB); PG8_STAGE(PG8_SA(0, 0), cA, voffA); PG8_STAGE(PG8_SA(0, 1), cA + hstepA, voffA);
    if (wr == 1) PG8_BAR;
    PG8_WAIT_V(2); PG8_BAR;
    PG8_STAGE(PG8_SB(1, 0), cB + kstep, voffB); PG8_STAGE(PG8_SA(1, 0), cA + kstep, voffA); PG8_STAGE(PG8_SB(1, 1), cB + hstepB + kstep, voffB);
    PG8_WAIT_V(6); PG8_BAR;
    for (;;) {
        const bool has_next = S.next(ui + 1, nxt);
        const char* nA = has_next ? S.aptr(nxt) : cA; const char* nB = has_next ? S.bptr(nxt) : cB;
        const int nt = cur.nt;
        auto kloop = [&](auto mqc) {
            constexpr int MQ = decltype(mqc)::v;
#define PG8_DO(ai, bj) (MQ < 0 || MQ == (ai) * 2 + (bj))
#define PG8_DOA(ai) (MQ < 0 || (MQ < 4 && (MQ >> 1) == (ai)))
#define PG8_DOB(bj) (MQ < 0 || (MQ < 4 && (MQ & 1) == (bj)))
#define PG8_WAIT_Q do { if constexpr (MQ < 0) PG8_WAIT_V(8); else PG8_WAIT_V(4); } while (0)
        for (int t = 0; t < nt; t += 2) {
            const bool last = (t == nt - 2);
            const char* a1 = cA + (size_t)(t + 1) * kstep;
            const char* a2 = last ? nA : cA + (size_t)(t + 2) * kstep; const char* b2 = last ? nB : cB + (size_t)(t + 2) * kstep;
            const char* a3 = a2 + kstep; const char* b3 = b2 + kstep;
            if (last && has_next) S.a_ready(nxt);
            if constexpr (PG8_DOB(0)) PG8_LDB(B0, 0, 0); if constexpr (PG8_DOB(1)) PG8_LDB(B1, 0, 1); PG8_SCHED; if constexpr (PG8_DOA(0)) PG8_LDA(At, 0, 0); if constexpr (PG8_DOA(1)) PG8_STAGE(PG8_SA(1, 1), a1 + hstepA, voffA);
            PG8_WAIT_Q; PG8_WAIT_L(0); PG8_BAR; if constexpr (PG8_DO(0, 0)) PG8_MMA(0, 0, At, B0); if constexpr (PG8_DO(0, 1)) PG8_MMA(0, 1, At, B1); PG8_BAR; PG8_SCHED;
            if constexpr (PG8_DOA(1)) PG8_LDA(At, 0, 1); if constexpr (PG8_DOB(0)) PG8_STAGE(PG8_SB(0, 0), b2, voffB); if constexpr (PG8_DOB(1)) PG8_STAGE(PG8_SB(0, 1), b2 + hstepB, voffB); if constexpr (PG8_DOA(0)) PG8_STAGE(PG8_SA(0, 0), a2, voffA);
            PG8_WAIT_Q; PG8_WAIT_L(0); PG8_BAR; if constexpr (PG8_DO(1, 0)) PG8_MMA(1, 0, At, B0); if constexpr (PG8_DO(1, 1)) PG8_MMA(1, 1, At, B1); PG8_BAR; PG8_SCHED;
            if constexpr (PG8_DOB(0)) PG8_LDB(B0, 1, 0); if constexpr (PG8_DOB(1)) PG8_LDB(B1, 1, 1); PG8_SCHED; if constexpr (PG8_DOA(0)) PG8_LDA(At, 1, 0); if constexpr (PG8_DOA(1)) PG8_STAGE(PG8_SA(0, 1), a2 + hstepA, voffA);
            PG8_WAIT_Q; PG8_WAIT_L(0); PG8_BAR; if constexpr (PG8_DO(0, 0)) PG8_MMA(0, 0, At, B0); if constexpr (PG8_DO(0, 1)) PG8_MMA(0, 1, At, B1); PG8_BAR; PG8_SCHED;
            if constexpr (PG8_DOA(1)) PG8_LDA(At, 1, 1); if constexpr (PG8_DOB(0)) PG8_STAGE(PG8_SB(1, 0), b3, voffB); if constexpr (PG8_DOB(1)) PG8_STAGE(PG8_SB(1, 1), b3 + hstepB, voffB); if constexpr (PG8_DOA(0)) PG8_STAGE(PG8_SA(1, 0), a3, voffA);
            PG8_WAIT_Q; PG8_WAIT_L(0); PG8_BAR; if constexpr (PG8_DO(1, 0)) PG8_MMA(1, 0, At, B0); if constexpr (PG8_DO(1, 1)) PG8_MMA(1, 1, At, B1); PG8_BAR; PG8_SCHED;
        }
#undef PG8_DO
#undef PG8_DOA
#undef PG8_DOB
#undef PG8_WAIT_Q
        };
        if constexpr (QT) { const int mq = (S.split == 2) ? cur.kq : -1;
            if (mq < 0) kloop(IC<-1>{}); else if (mq == 0) kloop(IC<0>{}); else if (mq == 1) kloop(IC<1>{}); else if (mq == 2) kloop(IC<2>{}); else kloop(IC<3>{}); }
        else kloop(IC<-1>{});
        if constexpr (ALIGN_EPI) { if (wr == 0) PG8_BAR; }
        if (cur.kq < 0) E(acc, cur, wr, wc, fr, fq); else E.partial(acc, cur, wr, wc);
        if (!has_next) break;
#pragma unroll
        for (int a = 0; a < 2; ++a)
#pragma unroll
            for (int b = 0; b < 2; ++b)
#pragma unroll
                for (int m = 0; m < 4; ++m)
#pragma unroll
                    for (int n = 0; n < 2; ++n) acc[a][b][m][n] = (f32x4){0.f, 0.f, 0.f, 0.f};
        cur = nxt; cA = nA; cB = nB; ++ui;
        if constexpr (ALIGN_EPI) { if (wr == 1) PG8_BAR; }
    }
    PG8_WAIT_V(0);
    if constexpr (!ALIGN_EPI) { if (wr == 0) PG8_BAR; }
    PG8_BAR;
#undef PG8_SA
#undef PG8_SB
#undef PG8_STAGE
#undef PG8_LDA
#undef PG8_LDA1
#undef PG8_LDB1
#undef PG8_LDB
#undef PG8_MMA
#undef PG8_WAIT_V
#undef PG8_WAIT_L
#undef PG8_BAR
#undef PG8_SCHED
}
}
typedef f32x4 Acc[2][2][4][2];
DI float log2g_of(int h) { return h == 0 ? -0.04580368961312479f : h == 1 ? -0.02272007650008353f : h == 2 ? -0.011315313227834146f : -0.005646563141142063f; }
DI u32x4 pack8f(f32x4 a, f32x4 b) { u32x4 w; w.x = cvt_pk_bf16(a[0], a[1]); w.y = cvt_pk_bf16(a[2], a[3]); w.z = cvt_pk_bf16(b[0], b[1]); w.w = cvt_pk_bf16(b[2], b[3]); return w; }
DI float fsilu(float x) { return x * __builtin_amdgcn_rcpf(1.0f + __builtin_amdgcn_exp2f(-1.4426950408889634f * x)); }
DI float fsigm(float x) { return __builtin_amdgcn_rcpf(1.0f + __builtin_amdgcn_exp2f(-1.4426950408889634f * x)); }
DI f32x4 silu4(f32x4 v) { return (f32x4){fsilu(v[0]), fsilu(v[1]), fsilu(v[2]), fsilu(v[3])}; }
DI float rs_of(const u64* ss, int row) { return __builtin_amdgcn_rsqf(ss_val(ss[row]) * (1.0f / DM) + EPS); }

#ifndef WINR
#define WINR 3
#endif
struct EpiIn {
    static constexpr bool QT = false;
    unsigned char* ws; float* out; int e, slot;
    DI void partial(const Acc&, const pg8::Unit&, int, int) const {}
    DI void operator()(const Acc& acc, const pg8::Unit& u, int wr, int wc, int fr_, int fq_) const {
        (void)fr_; (void)fq_; const int lane_ = opaque_tid() & 63; const int fr = lane_ & 15, fq = lane_ >> 4;
        const int row0 = u.pm * 256 + wr * 64 + fr, cb = wc * 32 + 8 * fq, pn = u.pn;
        const bool prompt = u.pm < (MP / 256);
        const u64* ss = (const u64*)(ws + WS_SS) + (size_t)slot * M; const f32x2* rope = (const f32x2*)(ws + WS_ROPE);
        bf16_t *QR = (bf16_t*)(ws + WS_QR), *QD = (bf16_t*)(ws + WS_QD), *KR = (bf16_t*)(ws + WS_KR), *KD = (bf16_t*)(ws + WS_KD), *VR = (bf16_t*)(ws + WS_VR), *GR = (bf16_t*)(ws + WS_GR);
        bf16_t *QF = (bf16_t*)(ws + WS_QF), *KF = (bf16_t*)(ws + WS_KF), *VF = (bf16_t*)(ws + WS_VF); float* QS32 = (float*)(ws + WS_QS32);
        float* oKp = out + O_KP + (size_t)e * MP * FW; float* oKs = out + O_KS + (size_t)e * MS * FW; float* oVp = out + O_VP + (size_t)e * MP * FW; float* oVs = out + O_VS + (size_t)e * MS * FW;
        if (pn < 8) {
            const int head = pn & 3; const bool isK = pn >= 4; const float l2g = log2g_of(head);
            bf16_t* P0 = isK ? KR : QR; bf16_t* P1 = isK ? KD : QD;
            constexpr int W = WINR;
            f32x4 tb[W][4]; u64 sv[W];
#define EI_LOAD(q) do { const int row = row0 + ((q) >> 2) * 128 + ((q) & 3) * 16; sv[(q) % W] = ss[row]; const f32x4* tp = (const f32x4*)(rope + (size_t)row_pos(row) * 128 + cb); \
                tb[(q) % W][0] = tp[0]; tb[(q) % W][1] = tp[1]; tb[(q) % W][2] = tp[2]; tb[(q) % W][3] = tp[3]; } while (0)
#pragma unroll
            for (int q = 0; q < W; ++q) EI_LOAD(q);
#pragma unroll
            for (int q = 0; q < 8; ++q) {
                asm volatile("" ::: "memory");
                {
                    const int ai = q >> 2, m = q & 3;
                    const int row = row0 + ai * 128 + m * 16; const int pos = row_pos(row), ci = pos & 63;
                    const float rs = __builtin_amdgcn_rsqf(ss_val(sv[q % W]) * (1.0f / DM) + EPS) * (isK ? 0.0625f : 1.0f);
                    const float dec = __builtin_amdgcn_exp2f(l2g * (isK ? (float)(63 - ci) : (float)(ci + 1)));
                    const f32x4 t0 = tb[q % W][0], t1 = tb[q % W][1], t2 = tb[q % W][2], t3 = tb[q % W][3];
                    const f32x4 a0 = acc[ai][0][m][0] * rs, a1 = acc[ai][0][m][1] * rs, b0 = acc[ai][1][m][0] * rs, b1 = acc[ai][1][m][1] * rs;
                    f32x4 lo0, lo1, hi0, hi1;
                    lo0[0] = a0[0] * t0[0] - b0[0] * t0[1]; hi0[0] = a0[0] * t0[1] + b0[0] * t0[0];
                    lo0[1] = a0[1] * t0[2] - b0[1] * t0[3]; hi0[1] = a0[1] * t0[3] + b0[1] * t0[2];
                    lo0[2] = a0[2] * t1[0] - b0[2] * t1[1]; hi0[2] = a0[2] * t1[1] + b0[2] * t1[0];
                    lo0[3] = a0[3] * t1[2] - b0[3] * t1[3]; hi0[3] = a0[3] * t1[3] + b0[3] * t1[2];
                    lo1[0] = a1[0] * t2[0] - b1[0] * t2[1]; hi1[0] = a1[0] * t2[1] + b1[0] * t2[0];
                    lo1[1] = a1[1] * t2[2] - b1[1] * t2[3]; hi1[1] = a1[1] * t2[3] + b1[1] * t2[2];
                    lo1[2] = a1[2] * t3[0] - b1[2] * t3[1]; hi1[2] = a1[2] * t3[1] + b1[2] * t3[0];
                    lo1[3] = a1[3] * t3[2] - b1[3] * t3[3]; hi1[3] = a1[3] * t3[3] + b1[3] * t3[2];
                    const size_t o = (size_t)row * RW + head * 256 + cb;
                    *(u32x4*)(P0 + o) = pack8f(lo0, lo1); *(u32x4*)(P0 + o + 128) = pack8f(hi0, hi1);
                    *(u32x4*)(P1 + o) = pack8f(lo0 * dec, lo1 * dec); *(u32x4*)(P1 + o + 128) = pack8f(hi0 * dec, hi1 * dec);
                }
                asm volatile("" ::: "memory");
                if (q + W < 8) EI_LOAD(q + W);
            }
#undef EI_LOAD
        } else if (pn < 16) {
            const bool isG = pn >= 12; bf16_t* P = isG ? GR : VR; const int cbase = (pn & 3) * 256 + cb;
            u64 sv[8];
#pragma unroll
            for (int q = 0; q < 8; ++q) sv[q] = ss[row0 + (q >> 2) * 128 + (q & 3) * 16];
#pragma unroll
            for (int ai = 0; ai < 2; ++ai)
#pragma unroll
                for (int m = 0; m < 4; ++m) {
                    const int row = row0 + ai * 128 + m * 16; const float rs = __builtin_amdgcn_rsqf(ss_val(sv[ai * 4 + m]) * (1.0f / DM) + EPS);
#pragma unroll
                    for (int bj = 0; bj < 2; ++bj) { f32x4 v0 = acc[ai][bj][m][0] * rs, v1 = acc[ai][bj][m][1] * rs;
                        if (isG) { v0 = silu4(v0); v1 = silu4(v1); }
                        *(u32x4*)(P + (size_t)row * RW + cbase + bj * 128) = pack8f(v0, v1); }
                }
        } else {
            const int kind = (pn - 16) >> 2; const int cbase = (pn & 3) * 256 + cb;
            bf16_t* Pb = kind == 0 ? QF : kind == 1 ? KF : VF;
            float* Po = prompt ? (kind == 1 ? oKp : oVp) : (kind == 1 ? oKs : oVs);
            u64 sv[8];
#pragma unroll
            for (int q = 0; q < 8; ++q) sv[q] = ss[row0 + (q >> 2) * 128 + (q & 3) * 16];
#pragma unroll
            for (int ai = 0; ai < 2; ++ai)
#pragma unroll
                for (int m = 0; m < 4; ++m) {
                    const int row = row0 + ai * 128 + m * 16; const float rs = __builtin_amdgcn_rsqf(ss_val(sv[ai * 4 + m]) * (1.0f / DM) + EPS); const int lrow = prompt ? row : row - MP;
#pragma unroll
                    for (int bj = 0; bj < 2; ++bj) { const f32x4 v0 = acc[ai][bj][m][0] * rs, v1 = acc[ai][bj][m][1] * rs; const size_t o = (size_t)lrow * FW + cbase + bj * 128;
                        if (kind == 0) { if (prompt) *(u32x4*)(Pb + o) = pack8f(v0, v1); else { *(f32x4*)(QS32 + o) = v0; *(f32x4*)(QS32 + o + 4) = v1; } }
                        else { *(f32x4*)(Po + o) = v0; *(f32x4*)(Po + o + 4) = v1; if (prompt) *(u32x4*)(Pb + o) = pack8f(v0, v1); } }
                }
        }
    }
};

#ifndef WIN0
#define WIN0 8
#endif
#ifndef WIN1
#define WIN1 4
#endif
DI void unpack8(u32x4 q, f32x4& lo, f32x4& hi) {
    lo = (f32x4){__uint_as_float(q.x << 16), __uint_as_float(q.x & 0xffff0000u), __uint_as_float(q.y << 16), __uint_as_float(q.y & 0xffff0000u)};
    hi = (f32x4){__uint_as_float(q.z << 16), __uint_as_float(q.z & 0xffff0000u), __uint_as_float(q.w << 16), __uint_as_float(q.w & 0xffff0000u)};
}
template <int MODE> struct EpiRes {
    static constexpr bool QT = true;
    const bf16_t* xold; bf16_t* xb; u64* ssq_out; const u64* ss_in; const bf16_t* pp; float* slab;
    template <int AI, int BJ> DI void quarter(const Acc& acc, const pg8::Unit& u, int wr, int wc) const {
        const int lane_ = opaque_tid() & 63; const int fr = lane_ & 15, fq = lane_ >> 4;
        const int row0 = u.pm * 256 + AI * 128 + wr * 64 + fr, col = u.pn * 256 + BJ * 128 + wc * 32 + 8 * fq;
        u32x4 xo[4], pw[4]; u64 rsv[4];
#pragma unroll
        for (int m = 0; m < 4; ++m) { const int row = row0 + m * 16; xo[m] = *(const u32x4*)(xold + (size_t)row * DM + col);
            if (MODE == 1) { rsv[m] = ss_in[row]; pw[m] = *(const u32x4*)(pp + (size_t)row * DM + col); } }
#pragma unroll
        for (int m = 0; m < 4; ++m) { const int row = row0 + m * 16;
            f32x4 o0, o1; unpack8(xo[m], o0, o1);
            f32x4 v0 = acc[AI][BJ][m][0], v1 = acc[AI][BJ][m][1];
            if (MODE == 1) { const float rs = __builtin_amdgcn_rsqf(ss_val(rsv[m]) * (1.0f / DM) + EPS); f32x4 p0, p1; unpack8(pw[m], p0, p1);
#pragma unroll
                for (int j = 0; j < 4; ++j) { v0[j] = fsigm(v0[j] * rs) * p0[j]; v1[j] = fsigm(v1[j] * rs) * p1[j]; } }
            o0 += v0; o1 += v1;
            *(u32x4*)(xb + (size_t)row * DM + col) = pack8f(o0, o1);
            float s = (o0[0] * o0[0] + o0[1] * o0[1]) + (o0[2] * o0[2] + o0[3] * o0[3]) + (o1[0] * o1[0] + o1[1] * o1[1]) + (o1[2] * o1[2] + o1[3] * o1[3]);
            s += shfl_xor_f(s, 16); s += shfl_xor_f(s, 32);
            if (fq == 0) __hip_atomic_fetch_add(ssq_out + row, ss_fix(s), __ATOMIC_RELAXED, __HIP_MEMORY_SCOPE_AGENT); }
    }
    DI void partial(const Acc& acc, const pg8::Unit& u, int wr, int wc) const {
        if (slab == nullptr) { if (u.kq == 0) quarter<0, 0>(acc, u, wr, wc); else if (u.kq == 1) quarter<0, 1>(acc, u, wr, wc); else if (u.kq == 2) quarter<1, 0>(acc, u, wr, wc); else quarter<1, 1>(acc, u, wr, wc); return; }
        const int lane_ = opaque_tid() & 63; const int fr = lane_ & 15, fq = lane_ >> 4;
        float* d = slab + (size_t)(u.li * 4 + u.kq) * 65536 + (size_t)(wr * 64 + fr) * 256 + wc * 32 + 8 * fq;
#pragma unroll
        for (int ai = 0; ai < 2; ++ai)
#pragma unroll
            for (int bj = 0; bj < 2; ++bj)
#pragma unroll
                for (int m = 0; m < 4; ++m) { float* p = d + (size_t)(ai * 128 + m * 16) * 256 + bj * 128; *(f32x4*)p = acc[ai][bj][m][0]; *(f32x4*)(p + 4) = acc[ai][bj][m][1]; }
    }
    DI void operator()(const Acc& acc, const pg8::Unit& u, int wr, int wc, int fr_, int fq_) const {
        (void)fr_; (void)fq_; const int lane_ = opaque_tid() & 63; const int fr = lane_ & 15, fq = lane_ >> 4;
        const int row0 = u.pm * 256 + wr * 64 + fr, col0 = u.pn * 256 + wc * 32 + 8 * fq;
        constexpr int W = (MODE == 1) ? WIN1 : WIN0;
        u32x4 xo[W][2]; u32x4 pw[W][2]; u64 rsv[W];
#define ER_LOAD(q) do { const int row = row0 + ((q) >> 2) * 128 + ((q) & 3) * 16; \
            if (MODE == 1) rsv[(q) % W] = ss_in[row]; \
            _Pragma("unroll") for (int bj = 0; bj < 2; ++bj) { xo[(q) % W][bj] = *(const u32x4*)(xold + (size_t)row * DM + col0 + bj * 128); \
                if (MODE == 1) pw[(q) % W][bj] = *(const u32x4*)(pp + (size_t)row * DM + col0 + bj * 128); } } while (0)
#pragma unroll
        for (int q = 0; q < W; ++q) ER_LOAD(q);
#pragma unroll
        for (int q = 0; q < 8; ++q) {
            asm volatile("" ::: "memory");
            {
                const int ai = q >> 2, m = q & 3, row = row0 + ai * 128 + m * 16;
                float rs = 1.f; if (MODE == 1) rs = __builtin_amdgcn_rsqf(ss_val(rsv[q % W]) * (1.0f / DM) + EPS);
                float s = 0.f;
#pragma unroll
                for (int bj = 0; bj < 2; ++bj) { const int col = col0 + bj * 128;
                    f32x4 o0, o1; unpack8(xo[q % W][bj], o0, o1);
                    f32x4 v0 = acc[ai][bj][m][0], v1 = acc[ai][bj][m][1];
                    if (MODE == 1) { f32x4 p0, p1; unpack8(pw[q % W][bj], p0, p1);
#pragma unroll
                        for (int j = 0; j < 4; ++j) { v0[j] = fsigm(v0[j] * rs) * p0[j]; v1[j] = fsigm(v1[j] * rs) * p1[j]; } }
                    o0 += v0; o1 += v1;
                    *(u32x4*)(xb + (size_t)row * DM + col) = pack8f(o0, o1);
                    s += (o0[0] * o0[0] + o0[1] * o0[1]) + (o0[2] * o0[2] + o0[3] * o0[3]) + (o1[0] * o1[0] + o1[1] * o1[1]) + (o1[2] * o1[2] + o1[3] * o1[3]); }
                s += shfl_xor_f(s, 16); s += shfl_xor_f(s, 32);
                if (fq == 0) __hip_atomic_fetch_add(ssq_out + row, ss_fix(s), __ATOMIC_RELAXED, __HIP_MEMORY_SCOPE_AGENT);
            }
            asm volatile("" ::: "memory");
            if (q + W < 8) ER_LOAD(q + W);
        }
#undef ER_LOAD
    }
};

struct EpiAct {
    static constexpr bool QT = false;
    const u64* ss; bf16_t* act;
    DI void partial(const Acc&, const pg8::Unit&, int, int) const {}
    DI void operator()(const Acc& acc, const pg8::Unit& u, int wr, int wc, int fr_, int fq_) const {
        (void)fr_; (void)fq_; const int lane_ = opaque_tid() & 63; const int fr = lane_ & 15, fq = lane_ >> 4;
        const int row0 = u.pm * 256 + wr * 64 + fr, col0 = u.pn * 128 + wc * 32 + 8 * fq;
#pragma unroll
        for (int ai = 0; ai < 2; ++ai)
#pragma unroll
            for (int m = 0; m < 4; ++m) {
                const int row = row0 + ai * 128 + m * 16; const float rs = rs_of(ss, row);
                const f32x4 g0 = acc[ai][0][m][0] * rs, g1 = acc[ai][0][m][1] * rs, u0 = acc[ai][1][m][0] * rs, u1 = acc[ai][1][m][1] * rs;
                *(u32x4*)(act + (size_t)row * LDF + col0) = pack8f(silu4(g0) * u0, silu4(g1) * u1);
            }
    }
};

struct EpiBf {
    static constexpr bool QT = false;
    bf16_t* O; int ldc;
    DI void partial(const Acc&, const pg8::Unit&, int, int) const {}
    DI void operator()(const Acc& acc, const pg8::Unit& u, int wr, int wc, int fr_, int fq_) const {
        (void)fr_; (void)fq_; const int lane_ = opaque_tid() & 63; const int fr = lane_ & 15, fq = lane_ >> 4;
        const int row0 = u.pm * 256 + wr * 64 + fr, col0 = u.pn * 256 + wc * 32 + 8 * fq;
#pragma unroll
        for (int ai = 0; ai < 2; ++ai)
#pragma unroll
            for (int m = 0; m < 4; ++m) {
                const int row = row0 + ai * 128 + m * 16;
#pragma unroll
                for (int bj = 0; bj < 2; ++bj) *(u32x4*)(O + (size_t)row * ldc + col0 + bj * 128) = pack8f(acc[ai][bj][m][0], acc[ai][bj][m][1]);
            }
    }
};

struct EpiNull {
    static constexpr bool QT = false;
    float* sink;
    DI void partial(const Acc& acc, const pg8::Unit&, int, int) const { if (acc[0][0][0][0][0] == 12345.678f) sink[opaque_tid()] = acc[1][1][3][1][3]; }
    DI void operator()(const Acc& acc, const pg8::Unit&, int, int, int, int) const { float s = 0.f;
#pragma unroll
        for (int a = 0; a < 2; ++a)
#pragma unroll
            for (int b = 0; b < 2; ++b)
#pragma unroll
                for (int m = 0; m < 4; ++m)
#pragma unroll
                    for (int n = 0; n < 2; ++n) s += (acc[a][b][m][n][0] + acc[a][b][m][n][1]) + (acc[a][b][m][n][2] + acc[a][b][m][n][3]);
        if (s == 12345.678f) sink[opaque_tid()] = s; }
};
struct Params {
    const float *x_p, *x_s, *p_p, *p_s, *state_ret, *cache_k, *cache_v, *cache_lf, *state_pool;
    const float *norm_mix, *w_in, *b_forget, *w_out, *w_pool, *pool_scale, *norm_ffn, *w_gate, *w_up, *w_down, *norm_ple, *ple_gate, *ple_proj, *final_norm;
    float* out; unsigned char* ws;
    int ph_lo, ph_hi;
};
static_assert(sizeof(Params) % 8 == 0, "no tail padding");
typedef const __attribute__((address_space(4))) Params CP;
DI CP* launder_cp(CP* p) { asm volatile("" : "+s"(p)); return p; }

struct WJob { const float* src; const float* src2; const float* gain; const float* cscale; bf16_t* dst; int K, ld, coloff, nphys, type, ldd; };
constexpr int NJOBS = 22;
DI int job_items(int j) {
    return j < 2 ? 16 * 112 : j < 4 ? 16 * 32 : j < 8 ? 16 * 176 : j < 12 ? 44 * 32 : j < 16 ? 16 * 32 : j < 20 ? 2 * 32 : 4 * 32;
}
DI WJob get_job(CP& P, int j) {
    WJob w; w.src2 = nullptr; w.gain = nullptr; w.cscale = nullptr; w.coloff = 0; w.type = 0; w.ldd = 0;
    unsigned char* ws = P.ws;
    if (j < 2) { const int e = j; w.src = P.w_in + (size_t)e * DM * INW; w.ld = INW; w.K = DM; w.nphys = INW_P; w.gain = P.norm_mix + (size_t)(2 * e) * DM; w.dst = (bf16_t*)(ws + WS_WIN) + (size_t)e * INW_P * DM; }
    else if (j < 4) { const int e = j - 2; w.src = P.w_out + (size_t)e * MIXW * DM; w.ld = DM; w.K = MIXW; w.nphys = DM; w.dst = (bf16_t*)(ws + WS_WOUT) + (size_t)e * DM * MIXW; }
    else if (j < 8) { const int i = j - 4; w.src = P.w_gate + (size_t)i * DM * DFF; w.src2 = P.w_up + (size_t)i * DM * DFF; w.ld = DFF; w.K = DM; w.nphys = 2 * DFF; w.type = 1;
        w.gain = P.norm_ffn + (size_t)i * DM; w.dst = (bf16_t*)(ws + WS_WGU) + (size_t)i * 2 * DFF * DM; }
    else if (j < 12) { const int i = j - 8; w.src = P.w_down + (size_t)i * DFF * DM; w.ld = DM; w.K = DFF; w.nphys = DM; w.dst = (bf16_t*)(ws + WS_WDN) + (size_t)i * DM * LDF; w.ldd = LDF; }
    else if (j < 16) { const int i = j - 12; w.src = P.ple_gate + (size_t)i * DM * DM; w.ld = DM; w.K = DM; w.nphys = DM; w.gain = P.norm_ple + (size_t)i * DM; w.dst = (bf16_t*)(ws + WS_WPG) + (size_t)i * DM * DM; }
    else if (j < 20) { const int i = j - 16; w.src = P.ple_proj + (size_t)i * PLE * DM; w.ld = DM; w.K = PLE; w.nphys = DM; w.dst = (bf16_t*)(ws + WS_WPP) + (size_t)i * DM * PLE; }
    else { const int o = j - 20; w.src = P.w_pool + (size_t)o * 4 * 512 * 512; w.ld = 512; w.K = 512; w.nphys = DM; w.type = 2; w.cscale = P.pool_scale + (size_t)o * DM; w.dst = (bf16_t*)(ws + WS_WPL) + (size_t)o * DM * 512; }
    if (w.ldd == 0) w.ldd = w.K;
    return w;
}
struct WItem { const float* src; const float* gain; const float* cs; bf16_t* dst; int ld, ldd; };
DI int seq_job(int pos) { return pos < 12 ? (int)((330613888146214976ull >> (5 * pos)) & 31) : (int)((540123756432429ull >> (5 * (pos - 12))) & 31); }
#ifndef FILL_ON
#define FILL_ON 0
#endif
constexpr int NPRO = FILL_ON ? 7424 : 24064, NREST = FILL_ON ? 16640 : 0, QL1 = 4736, QL2 = 7040, QL3 = 11776;
DI WItem get_item(CP& P, int it) {
    int pos = 0;
    for (; pos < NJOBS - 1; ++pos) { const int n = job_items(seq_job(pos)); if (it < n) break; it -= n; }
    const WJob w = get_job(P, seq_job(pos));
    const int npt = w.nphys / 128, kt = it / npt, pt = it - kt * npt, k0 = kt * 64, p0 = pt * 128;
    WItem r; r.ld = w.ld; r.ldd = w.ldd; r.gain = w.gain ? w.gain + k0 : nullptr; r.cs = w.cscale ? w.cscale + p0 : nullptr; r.dst = w.dst + (size_t)p0 * w.ldd + k0;
    const float* s = w.src; int c0 = w.coloff + p0;
    if (w.type == 1) { const int t256 = p0 >> 8, within = p0 & 255; if (within >= 128) s = w.src2; c0 = t256 * 128 + (within & 127); }
    else if (w.type == 2) { s = w.src + (size_t)(p0 >> 9) * 512 * 512; c0 = p0 & 511; }
    r.src = s + (size_t)k0 * w.ld + c0;
    return r;
}
constexpr int NWITEMS = 2 * 16 * 112 + 2 * 16 * 32 + 4 * 16 * 176 + 4 * 44 * 32 + 4 * 16 * 32 + 4 * 2 * 32 + 2 * 4 * 32;

DI void sincos_d(double a, float& c, float& s) {
    const double q = __builtin_rint(a * 0.63661977236758134308);
    double y = __builtin_fma(-q, 1.57079632679489655800e+00, a); y = __builtin_fma(-q, 6.12323399573676603587e-17, y);
    const double y2 = y * y;
    double sp = 1.0 / 6227020800.0; sp = sp * y2 - 1.0 / 39916800.0; sp = sp * y2 + 1.0 / 362880.0; sp = sp * y2 - 1.0 / 5040.0; sp = sp * y2 + 1.0 / 120.0; sp = sp * y2 - 1.0 / 6.0; sp = sp * y2 * y + y;
    double cp = 1.0 / 479001600.0; cp = cp * y2 - 1.0 / 3628800.0; cp = cp * y2 + 1.0 / 40320.0; cp = cp * y2 - 1.0 / 720.0; cp = cp * y2 + 1.0 / 24.0; cp = cp * y2 - 0.5; cp = cp * y2 + 1.0;
    const int qi = (int)((long long)q & 3);
    const double ss = (qi == 0) ? sp : (qi == 1) ? cp : (qi == 2) ? -sp : -cp;
    const double cc = (qi == 0) ? cp : (qi == 1) ? -sp : (qi == 2) ? -cp : sp;
    c = (float)cc; s = (float)ss;
}

constexpr int CV_TS = 272;
DI int invperm32(int L) { return 16 * ((L >> 2) & 1) + 4 * (L >> 3) + (L & 3); }
DI void cv_store_tile(LAS unsigned char* T, const WItem& w, const f32x4 (&v)[4], int kk, int seg) {
    f32x4 cs4 = {1.f, 1.f, 1.f, 1.f}; if (w.cs) cs4 = *(const f32x4*)(w.cs + 4 * seg);
#pragma unroll
    for (int i = 0; i < 4; ++i) { const int k = kk + 16 * i; const float g = w.gain ? w.gain[k] : 1.0f; const f32x4 x = v[i] * g * cs4;
        u32x2 pk; pk.x = cvt_pk_bf16(x[0], x[1]); pk.y = cvt_pk_bf16(x[2], x[3]); *(LAS u32x2*)(T + k * CV_TS + seg * 8) = pk; }
}
DI void cv_emit(LAS unsigned char* T, const WItem& w, int wave, int lane) {
    const int s = 4 * wave + (lane >> 4), nb = s & 7, k0 = 16 * (s >> 3);
    const int i = lane & 15, q = i >> 2, p = i & 3, n = 16 * nb + i;
    const int ip = (n & ~31) + invperm32(n & 31);
    const unsigned a0 = (unsigned)(size_t)T + (unsigned)((k0 + q) * CV_TS + (16 * nb + 4 * p) * 2);
    s16x4 r0, r1, r2, r3;
    asm volatile("ds_read_b64_tr_b16 %0, %4\n\tds_read_b64_tr_b16 %1, %4 offset:1088\n\tds_read_b64_tr_b16 %2, %4 offset:2176\n\tds_read_b64_tr_b16 %3, %4 offset:3264\n\ts_waitcnt lgkmcnt(0)"
                 : "=&v"(r0), "=&v"(r1), "=&v"(r2), "=&v"(r3) : "v"(a0) : "memory");
    __builtin_amdgcn_sched_barrier(0);
    bf16_t* d = w.dst + (size_t)ip * w.ldd + k0;
    *(bf16x8*)d = __builtin_shufflevector(r0, r1, 0, 1, 2, 3, 4, 5, 6, 7);
    *(bf16x8*)(d + 8) = __builtin_shufflevector(r2, r3, 0, 1, 2, 3, 4, 5, 6, 7);
}

DI void convert_fill(CP& P, LAS unsigned char* lds, unsigned* head, volatile LAS unsigned* slot, int limit, int budget) {
    const int tid = opaque_tid();
    const int kk = tid >> 5, seg = tid & 31, lane = tid & 63, wave = tid >> 6;
    (void)budget;
#define CF_TAKE(dst) do { if (tid == 0) { const unsigned h_ = __hip_atomic_load(head, __ATOMIC_RELAXED, __HIP_MEMORY_SCOPE_AGENT); unsigned r_ = 0xffffffffu; \
        if (h_ < (unsigned)limit) { r_ = __hip_atomic_fetch_add(head, 4u, __ATOMIC_RELAXED, __HIP_MEMORY_SCOPE_AGENT); if (r_ >= (unsigned)NREST) r_ = 0xffffffffu; } *slot = r_; } \
        LDS_BARRIER(); dst = *slot; LDS_BARRIER(); } while (0)
#define CF_LOAD4(V, base) do { _Pragma("unroll") for (int b_ = 0; b_ < 4; ++b_) { const WItem w_ = get_item(P, NPRO + (int)(base) + b_); \
        _Pragma("unroll") for (int i = 0; i < 4; ++i) V[b_ * 4 + i] = *(const f32x4*)(w_.src + (size_t)(kk + 16 * i) * w_.ld + 4 * seg); } } while (0)
#define CF_PROC4(V, base) do { _Pragma("unroll") for (int b_ = 0; b_ < 4; ++b_) { const WItem w_ = get_item(P, NPRO + (int)(base) + b_); \
        const f32x4 (&vv_)[4] = *(const f32x4 (*)[4])&V[b_ * 4]; \
        cv_store_tile((LAS unsigned char*)lds, w_, vv_, kk, seg); \
        LDS_BARRIER(); \
        cv_emit((LAS unsigned char*)lds, w_, wave, lane); \
        LDS_BARRIER(); } } while (0)
    f32x4 va[16], vb[16];
    unsigned ia, ib;
    CF_TAKE(ia);
    if (ia == 0xffffffffu) return;
    CF_LOAD4(va, ia);
    for (;;) {
        CF_TAKE(ib);
        if (ib != 0xffffffffu) CF_LOAD4(vb, ib);
        CF_PROC4(va, ia);
        if (ib == 0xffffffffu) break;
        CF_TAKE(ia);
        if (ia != 0xffffffffu) CF_LOAD4(va, ia);
        CF_PROC4(vb, ib);
        if (ia == 0xffffffffu) break;
    }
#undef CF_TAKE
#undef CF_LOAD4
#undef CF_PROC4
}

DI void prologue(CP& P, LAS unsigned char* lds) {
    const int tid = opaque_tid(), lane = tid & 63, wave = tid >> 6, blk = blockIdx.x;
    unsigned char* ws = P.ws;
    {
        const int kk = tid >> 5, seg = tid & 31;
        f32x4 v[4];
        int it = blk;
        WItem cur = get_item(P, it < NPRO ? it : 0);
        if (it < NPRO) {
#pragma unroll
            for (int i = 0; i < 4; ++i) v[i] = *(const f32x4*)(cur.src + (size_t)(kk + 16 * i) * cur.ld + 4 * seg);
        }
        while (it < NPRO) {
            cv_store_tile(lds, cur, v, kk, seg);
            const int itn = it + NBLK;
            WItem nxt = cur;
            if (itn < NPRO) { nxt = get_item(P, itn);
#pragma unroll
                for (int i = 0; i < 4; ++i) v[i] = *(const f32x4*)(nxt.src + (size_t)(kk + 16 * i) * nxt.ld + 4 * seg); }
            LDS_BARRIER();
            cv_emit(lds, cur, wave, lane);
            LDS_BARRIER();
            cur = nxt; it = itn;
        }
    }
    const int gt = blk * NTHR + tid, NT = NBLK * NTHR;
    {
        bf16_t* PB = (bf16_t*)(ws + WS_PB);
        for (int i = gt; i < 4 * M * PLE / 8; i += NT) {
            const int e8 = i * 8, l = e8 / (M * PLE), rem = e8 - l * (M * PLE), m = rem / PLE, c = rem - m * PLE;
            const float* s = m < MP ? P.p_p + ((size_t)l * MP + m) * PLE + c : P.p_s + ((size_t)l * MS + (m - MP)) * PLE + c;
            *(u32x4*)(PB + (size_t)e8) = pack8f(*(const f32x4*)s, *(const f32x4*)(s + 4));
        }
    }
    {
        f32x2* R = (f32x2*)(ws + WS_ROPE);
        for (int i = gt; i < 4096 * 128; i += NT) { const int pos = i >> 7, j = i & 127;
            const double inv = exp2(-(double)j * (13.287712379549449 / 128.0));
            float c, s; sincos_d((double)pos * inv, c, s); R[i] = (f32x2){c, s}; }
    }
    {
        float* G = (float*)(ws + WS_GWF);
        for (int i = gt; i < 2 * DM * 8; i += NT) { const int e = i / (DM * 8), r = i - e * DM * 8, j = r / DM, k = r - j * DM;
            G[i] = P.norm_mix[(size_t)(2 * e) * DM + k] * P.w_in[((size_t)e * DM + k) * INW + INW_P + j]; }
    }
    {
        bf16_t* XB = (bf16_t*)(ws + WS_XB0); u64* SS = (u64*)(ws + WS_SS);
        for (int m = blk * 8 + wave; m < M; m += NBLK * 8) {
            const float* xr = m < MP ? P.x_p + (size_t)m * DM : P.x_s + (size_t)(m - MP) * DM;
            float s = 0.f;
#pragma unroll
            for (int j = 0; j < 4; ++j) { const f32x4 a = *(const f32x4*)(xr + j * 512 + lane * 8), b = *(const f32x4*)(xr + j * 512 + lane * 8 + 4);
                s += (a[0] * a[0] + a[1] * a[1]) + (a[2] * a[2] + a[3] * a[3]) + (b[0] * b[0] + b[1] * b[1]) + (b[2] * b[2] + b[3] * b[3]);
                *(u32x4*)(XB + (size_t)m * DM + j * 512 + lane * 8) = pack8f(a, b); }
            s = wave_sum(s);
            if (lane == 0) SS[m] = ss_fix(s);
        }
    }
}

template <class TX>
DI void fgate_units(CP& P, LAS unsigned char* lds, int e, const TX* xin_p, const TX* xin_s, const u64* ss) {
    const int tid = opaque_tid(), lane = tid & 63, wave = tid >> 6, blk = blockIdx.x;
    LAS float* G = (LAS float*)lds;
    const float* gsrc = (const float*)(P.ws + WS_GWF) + (size_t)e * DM * 8;
    for (int i = tid; i < DM * 8 / 4; i += NTHR) *(LAS f32x4*)(G + i * 4) = *(const f32x4*)(gsrc + i * 4);
    __syncthreads();
    for (int m = (blk - 96) * 8 + wave; blk >= 96 && m < M; m += 160 * 8) {
        const TX* xr = m < MP ? xin_p + (size_t)m * DM : xin_s + (size_t)(m - MP) * DM;
        asm volatile("" ::: "memory");
        float a[8] = {0.f, 0.f, 0.f, 0.f, 0.f, 0.f, 0.f, 0.f};
#pragma unroll
        for (int j = 0; j < 8; ++j) { const int k0 = j * 256 + lane * 4; f32x4 xv;
            if constexpr (sizeof(TX) == 4) xv = *(const f32x4*)(xr + k0);
            else { const u32x2 q_ = *(const u32x2*)(xr + k0); xv = (f32x4){__uint_as_float(q_.x << 16), __uint_as_float(q_.x & 0xffff0000u), __uint_as_float(q_.y << 16), __uint_as_float(q_.y & 0xffff0000u)}; }
#pragma unroll
            for (int t = 0; t < 8; ++t) { const f32x4 g = *(LAS f32x4*)(G + t * DM + k0);
                a[t] += (xv[0] * g[0] + xv[1] * g[1]) + (xv[2] * g[2] + xv[3] * g[3]); } }
#pragma unroll
        for (int j = 0; j < 8; ++j) a[j] = wave_sum(a[j]);
        if (lane < 8) {
            float v = a[0];
#pragma unroll
            for (int j = 1; j < 8; ++j) v = (lane == j) ? a[j] : v;
            const float z = v * rs_of(ss, m) + P.b_forget[e * 8 + lane];
            float ln2 = 0.6931471805599453f; asm volatile("" : "+v"(ln2));
            const float lf = fminf(z, 0.f) - ln2 * __builtin_amdgcn_logf(1.0f + __builtin_amdgcn_exp2f(-1.4426950408889634f * fabsf(z)));
            float* o = m < MP ? P.out + O_LP + ((size_t)e * MP + m) * 8 : P.out + O_LS + ((size_t)e * MS + (m - MP)) * 8;
            o[lane] = lf;
        }
    }
    __syncthreads();
}
namespace rt {
#define MFMA32(a, b, c) __builtin_amdgcn_mfma_f32_32x32x16_bf16((a), (b), (c), 0, 0, 0)
DI unsigned off_b(unsigned row, unsigned ch) { return 256u * row + 16u * (ch ^ (((row & 3) << 2) | ((row >> 2) & 3))); }
DI int crow(int reg, int h) { return (reg & 3) + 8 * (reg >> 2) + 4 * h; }
DI bf16x8 pack_step(const f32x16& x, int s) {
    u32x4 p;
    p.x = cvt_pk_bf16(x[8 * s + 0], x[8 * s + 1]); p.y = cvt_pk_bf16(x[8 * s + 2], x[8 * s + 3]); p.z = cvt_pk_bf16(x[8 * s + 4], x[8 * s + 5]); p.w = cvt_pk_bf16(x[8 * s + 6], x[8 * s + 7]);
    return __builtin_bit_cast(bf16x8, p);
}
DI unsigned tr_addr(unsigned img, unsigned row0, unsigned c, unsigned lane) {
    const unsigned blk = (lane >> 4) & 1, q = (lane & 15) >> 2, p = lane & 3;
    return img + off_b(row0 + q, 4 * c + 2 * blk + (p >> 1)) + 8 * (p & 1);
}
DI bf16x8 cat8(s16x4 lo, s16x4 hi) { return __builtin_shufflevector(lo, hi, 0, 1, 2, 3, 4, 5, 6, 7); }
DI void tr_read8(const unsigned (&a)[8], bf16x8 (&f)[4]) {
    s16x4 r0, r1, r2, r3, r4, r5, r6, r7;
    asm volatile("ds_read_b64_tr_b16 %0, %8\n\tds_read_b64_tr_b16 %1, %9\n\tds_read_b64_tr_b16 %2, %10\n\tds_read_b64_tr_b16 %3, %11\n\t"
                 "ds_read_b64_tr_b16 %4, %12\n\tds_read_b64_tr_b16 %5, %13\n\tds_read_b64_tr_b16 %6, %14\n\tds_read_b64_tr_b16 %7, %15\n\ts_waitcnt lgkmcnt(0)"
                 : "=&v"(r0), "=&v"(r1), "=&v"(r2), "=&v"(r3), "=&v"(r4), "=&v"(r5), "=&v"(r6), "=&v"(r7)
                 : "v"(a[0]), "v"(a[1]), "v"(a[2]), "v"(a[3]), "v"(a[4]), "v"(a[5]), "v"(a[6]), "v"(a[7]) : "memory");
    f[0] = cat8(r0, r1); f[1] = cat8(r2, r3); f[2] = cat8(r4, r5); f[3] = cat8(r6, r7);
}
DI void tr_frags4_nat(unsigned img, unsigned ks0, unsigned c, unsigned lane, bf16x8 (&f)[4]) {
    const unsigned h = lane >> 5; unsigned a[8];
#pragma unroll
    for (int s = 0; s < 4; ++s) { a[2 * s] = tr_addr(img, 16 * (ks0 + s) + 8 * h, c, lane); a[2 * s + 1] = tr_addr(img, 16 * (ks0 + s) + 8 * h + 4, c, lane); }
    tr_read8(a, f);
}
DI void tr_frags4_acc(unsigned img, unsigned c, unsigned lane, bf16x8 (&f)[4]) {
    const unsigned h = lane >> 5; unsigned a[8];
#pragma unroll
    for (int s = 0; s < 4; ++s) { a[2 * s] = tr_addr(img, 16 * s + 4 * h, c, lane); a[2 * s + 1] = tr_addr(img, 16 * s + 8 + 4 * h, c, lane); }
    tr_read8(a, f);
}
DI bf16x8 row_frag(LAS unsigned char* img, unsigned row, unsigned s, unsigned h) { return *(LAS bf16x8*)(img + off_b(row, 2 * s + h)); }

DI void load_tile64x256(LAS unsigned char* dst, const bf16_t* src, int ld) {
    const int tid = opaque_tid();
    u32x4 v[4];
#pragma unroll
    for (int i = 0; i < 4; ++i) { const int q = tid + 512 * i, row = q >> 5, cch = q & 31; v[i] = *(const u32x4*)(src + (size_t)row * ld + cch * 8); }
#pragma unroll
    for (int i = 0; i < 4; ++i) { const int q = tid + 512 * i, row = q >> 5, cch = q & 31; *(LAS u32x4*)(dst + (cch >> 4) * 16384 + off_b(row, cch & 15)) = v[i]; }
}

DI void ab_unit(LAS unsigned char* lds, int bh, int eb, const bf16_t* KD, const bf16_t* VR, bf16_t* Sprev, float* Sfinal) {
    const int tid = opaque_tid(), lane = tid & 63, w = __builtin_amdgcn_readfirstlane(tid >> 6), r = lane & 31, hh = lane >> 5;
    const int b = bh >> 2, h = launder_i(bh & 3);
    const float sdec = __builtin_amdgcn_exp2f(log2g_of(h) * 64.0f);
    const bf16_t* kd0 = KD + (size_t)(b * SEQ) * RW + h * 256;
    const bf16_t* v0 = VR + (size_t)(b * SEQ) * RW + h * 256 + (eb >> 2) * 128;
    u32x4 sk[4], sv[2];
#define AB_LOAD(c) do { _Pragma("unroll") for (int i = 0; i < 4; ++i) { const int q = tid + 512 * i, row = q >> 5, cch = q & 31; sk[i] = *(const u32x4*)(kd0 + (size_t)((c) * 64 + row) * RW + cch * 8); } \
        _Pragma("unroll") for (int i = 0; i < 2; ++i) { const int q = tid + 512 * i, row = q >> 4, cch = q & 15; sv[i] = *(const u32x4*)(v0 + (size_t)((c) * 64 + row) * RW + cch * 8); } } while (0)
#define AB_WRITE(bb) do { LAS unsigned char* d_ = lds + (bb) * 49152; \
        _Pragma("unroll") for (int i = 0; i < 4; ++i) { const int q = tid + 512 * i, row = q >> 5, cch = q & 31; *(LAS u32x4*)(d_ + (cch >> 4) * 16384 + off_b(row, cch & 15)) = sk[i]; } \
        _Pragma("unroll") for (int i = 0; i < 2; ++i) { const int q = tid + 512 * i, row = q >> 4, cch = q & 15; *(LAS u32x4*)(d_ + 32768 + off_b(row, cch)) = sv[i]; } } while (0)
    f32x16 acc; for (int i = 0; i < 16; ++i) acc[i] = 0.f;
    AB_LOAD(0); AB_WRITE(0);
    LDS_BARRIER();
    const unsigned lbase = (unsigned)(size_t)lds;
    bf16_t* sp = Sprev + (size_t)bh * 64 * 65536 + (size_t)(32 * w) * 256 + 32 * eb + r;
    for (int c = 0; c < 64; ++c) {
        if (c + 1 < 64) AB_LOAD(c + 1);
#pragma unroll
        for (int i = 0; i < 16; ++i) sp[(size_t)c * 65536 + (size_t)crow(i, hh) * 256] = f2bf(acc[i]);
        const unsigned ib = lbase + (c & 1) * 49152;
        bf16x8 af[4], bfr[4];
        tr_frags4_nat(ib + (w >> 2) * 16384, 0, w & 3, lane, af); tr_frags4_nat(ib + 32768, 0, eb & 3, lane, bfr);
#pragma unroll
        for (int i = 0; i < 16; ++i) acc[i] *= sdec;
#pragma unroll
        for (int s = 0; s < 4; ++s) acc = MFMA32(af[s], bfr[s], acc);
        if (c + 1 < 64) { AB_WRITE((c + 1) & 1); }
        LDS_BARRIER();
    }
    float* so = Sfinal + (size_t)bh * 65536 + (size_t)(32 * w) * 256 + 32 * eb + r;
#pragma unroll
    for (int i = 0; i < 16; ++i) so[(size_t)crow(i, hh) * 256] = acc[i];
#undef AB_LOAD
#undef AB_WRITE
}

template <bool SAMPLE>
DI void c_unit(LAS unsigned char* lds, int row0  , int h, const bf16_t* QR, const bf16_t* QD, const bf16_t* KR, const bf16_t* KD, const bf16_t* VR, const bf16_t* GR,
               const void* Sp_, float* Snew, bf16_t* MIXA) {
    const int tid = opaque_tid(), lane = tid & 63, w = __builtin_amdgcn_readfirstlane(tid >> 6), r = lane & 31, hh = lane >> 5;
    LAS unsigned char* R0 = lds; LAS unsigned char* R1 = lds + 32768; LAS unsigned char* R2 = lds + 65536; LAS unsigned char* R3 = lds + 98304;
    const unsigned lbase = (unsigned)(size_t)lds;
    const float l2g = log2g_of(launder_i(h));
    const size_t goff = (size_t)row0 * RW + h * 256;
    {
        const bf16_t* srcs[4] = {QR + goff, KR + goff, VR + goff, QD + goff};
        u32x4 v[4][4];
#pragma unroll
        for (int t = 0; t < 4; ++t)
#pragma unroll
            for (int i = 0; i < 4; ++i) { const int q = tid + 512 * i, row = q >> 5, cch = q & 31; v[t][i] = *(const u32x4*)(srcs[t] + (size_t)row * RW + cch * 8); }
#pragma unroll
        for (int t = 0; t < 4; ++t)
#pragma unroll
            for (int i = 0; i < 4; ++i) { const int q = tid + 512 * i, row = q >> 5, cch = q & 31; *(LAS u32x4*)(lds + t * 32768 + (cch >> 4) * 16384 + off_b(row, cch & 15)) = v[t][i]; }
    }
    LDS_BARRIER();
    f32x16 o[2];
#pragma unroll
    for (int ib = 0; ib < 2; ++ib) {
        bf16x8 pf[2][2];
#pragma unroll
        for (int jb = 0; jb < 2; ++jb) {
            f32x16 x; for (int i = 0; i < 16; ++i) x[i] = 0.f;
#pragma unroll
            for (int s = 0; s < 16; ++s) x = MFMA32(row_frag(R1 + (s >> 3) * 16384, 32 * jb + r, s & 7, hh), row_frag(R0 + (s >> 3) * 16384, 32 * ib + r, s & 7, hh), x);
#pragma unroll
            for (int i = 0; i < 16; ++i) { const int dlt = (32 * ib + r) - (32 * jb + crow(i, hh)); x[i] *= __builtin_amdgcn_exp2f(l2g * (float)(dlt < 0 ? -dlt : dlt)); }
            pf[jb][0] = pack_step(x, 0); pf[jb][1] = pack_step(x, 1);
        }
        f32x16 a; for (int i = 0; i < 16; ++i) a[i] = 0.f;
        bf16x8 vf[4]; tr_frags4_acc(lbase + 65536 + (w >> 2) * 16384, w & 3, lane, vf);
#pragma unroll
        for (int jb = 0; jb < 2; ++jb)
#pragma unroll
            for (int s = 0; s < 2; ++s) a = MFMA32(pf[jb][s], vf[2 * jb + s], a);
        o[ib] = a;
    }
    LDS_BARRIER();
#pragma unroll 1
    for (int dh = 0; dh < 2; ++dh) {
        if (SAMPLE) {
            const float* S0 = (const float*)Sp_ + (size_t)(dh * 128) * 256;
#pragma unroll
            for (int bq = 0; bq < 2; ++bq) {
                f32x4 v[8];
#pragma unroll
                for (int i = 0; i < 4; ++i) { const int q = tid + 512 * (bq * 4 + i), d = q >> 5, cch = q & 31; v[2 * i] = *(const f32x4*)(S0 + (size_t)d * 256 + cch * 8); v[2 * i + 1] = *(const f32x4*)(S0 + (size_t)d * 256 + cch * 8 + 4); }
#pragma unroll
                for (int i = 0; i < 4; ++i) { const int q = tid + 512 * (bq * 4 + i), d = q >> 5, cch = q & 31; *(LAS u32x4*)(R0 + (cch >> 4) * 32768 + off_b(d, cch & 15)) = pack8f(v[2 * i], v[2 * i + 1]); }
            }
        } else {
            const bf16_t* S0 = (const bf16_t*)Sp_ + (size_t)(dh * 128) * 256;
            u32x4 v[8];
#pragma unroll
            for (int i = 0; i < 8; ++i) { const int q = tid + 512 * i, d = q >> 5, cch = q & 31; v[i] = *(const u32x4*)(S0 + (size_t)d * 256 + cch * 8); }
#pragma unroll
            for (int i = 0; i < 8; ++i) { const int q = tid + 512 * i, d = q >> 5, cch = q & 31; *(LAS u32x4*)(R0 + (cch >> 4) * 32768 + off_b(d, cch & 15)) = v[i]; }
        }
        LDS_BARRIER();
#pragma unroll
        for (int s4 = 0; s4 < 2; ++s4) {
            bf16x8 bs[4]; tr_frags4_nat(lbase + (w >> 2) * 32768, 4 * s4, w & 3, lane, bs);
#pragma unroll
            for (int s = 0; s < 4; ++s)
#pragma unroll
                for (int ib = 0; ib < 2; ++ib) o[ib] = MFMA32(row_frag(R3 + dh * 16384, 32 * ib + r, 4 * s4 + s, hh), bs[s], o[ib]);
        }
        LDS_BARRIER();
    }
    LAS float* red = (LAS float*)R0;
    LAS float* rsb = red + 512;
#pragma unroll
    for (int ib = 0; ib < 2; ++ib)
#pragma unroll
        for (int i = 0; i < 16; ++i) { float s = o[ib][i] * o[ib][i];
            s += shfl_xor_f(s, 1); s += shfl_xor_f(s, 2); s += shfl_xor_f(s, 4); s += shfl_xor_f(s, 8); s += shfl_xor_f(s, 16);
            if (r == 0) red[w * 64 + 32 * ib + crow(i, hh)] = s; }
    LDS_BARRIER();
    if (tid < 64) { float t = 0.f;
#pragma unroll
        for (int k = 0; k < 8; ++k) t += red[k * 64 + tid];
        rsb[tid] = __builtin_amdgcn_rsqf(t * (1.0f / 256.0f) + EPS); }
    LDS_BARRIER();
    {
        LAS unsigned char* OB = lds + 4096;
        u32x4 gq[4];
#pragma unroll
        for (int j = 0; j < 4; ++j) { const int c = tid + 512 * j, tok = c >> 5, ch = c & 31; gq[j] = *(const u32x4*)(GR + (size_t)(row0 + tok) * RW + h * 256 + ch * 8); }
#pragma unroll
        for (int ib = 0; ib < 2; ++ib)
#pragma unroll
            for (int i = 0; i < 16; ++i) { const int tok = 32 * ib + crow(i, hh); *(LAS bf16_t*)(OB + tok * 528 + (32 * w + r) * 2) = f2bf(o[ib][i] * rsb[tok]); }
        LDS_BARRIER();
#pragma unroll
        for (int j = 0; j < 4; ++j) { const int c = tid + 512 * j, tok = c >> 5, ch = c & 31;
            f32x4 a0, a1, g0, g1; unpack8(*(LAS u32x4*)(OB + tok * 528 + ch * 16), a0, a1); unpack8(gq[j], g0, g1);
            *(u32x4*)(MIXA + (size_t)(row0 + tok) * DM + h * 256 + ch * 8) = pack8f(a0 * g0, a1 * g1); }
    }
    if (SAMPLE) {
        LDS_BARRIER();
        load_tile64x256(R0, KD + goff, RW);
        LDS_BARRIER();
        const float sdec = __builtin_amdgcn_exp2f(l2g * 64.0f);
        bf16x8 af[4]; tr_frags4_nat(lbase + (w >> 2) * 16384, 0, w & 3, lane, af);
        const float* S0 = (const float*)Sp_;
#pragma unroll 1
        for (int eb = 0; eb < 8; ++eb) {
            f32x16 a; for (int i = 0; i < 16; ++i) a[i] = 0.f;
            bf16x8 vf[4]; tr_frags4_nat(lbase + 65536 + (eb >> 2) * 16384, 0, eb & 3, lane, vf);
#pragma unroll
            for (int s = 0; s < 4; ++s) a = MFMA32(af[s], vf[s], a);
#pragma unroll
            for (int i = 0; i < 16; ++i) { const size_t ix = (size_t)(32 * w + crow(i, hh)) * 256 + 32 * eb + r; Snew[ix] = sdec * S0[ix] + a[i]; }
        }
    }
    LDS_BARRIER();
}
}
namespace fa {
template <class A, class Bt> struct same_t { static constexpr bool v = false; };
template <class A> struct same_t<A, A> { static constexpr bool v = true; };
constexpr int D = 128, LD = 1024, LDO = 2048;
constexpr bool WSKIP = false;
constexpr float THR = 8.f;
constexpr float SCALE = 0.08838834764831845f;
constexpr int NW = 8, QBLK = 32, KVBLK = 64, QB = NW * QBLK;
constexpr int SHM_V = KVBLK * D * 2, SHM_K = KVBLK * D * 2;
constexpr int OFF_BIAS = 2 * SHM_V + 2 * SHM_K + NW * 64 * 4;
constexpr int BIAS_MAX = 4096 + 64;
constexpr int LDS_BYTES = OFF_BIAS + BIAS_MAX * 4;
static_assert(LDS_BYTES <= LDS_MAIN, "attention LDS");
#define KSWZ(row, colB) ((row) * 256 + ((colB) ^ (((row) & 7) << 4)))
#define SBAR() __builtin_amdgcn_sched_barrier(0)
__device__ __forceinline__ int v_st(int k, int c) { const int kk = (k & ~0xC) | ((k & 4) << 1) | ((k & 8) >> 1); return ((kk >> 3) * 4 + (c >> 5)) * 512 + ((kk & 7) * 32 + (c & 31)) * 2; }
__device__ __forceinline__ int v_rd_base(int lane) { return ((lane & 3) << 3) | (((lane >> 2) & 3) << 6) | (((lane >> 4) & 1) << 5) | (((lane >> 5) & 1) << 8); }
constexpr int v_rd_off(int d0, int ks, int half) { return d0 * 512 + ks * 4096 + half * 2048; }
__device__ __forceinline__ int crow(int r, int hi) { return (r & 3) + 8 * (r >> 2) + 4 * hi; }
__device__ __forceinline__ unsigned cvtpk(float lo, float hi) {
    unsigned r; asm volatile("v_cvt_pk_bf16_f32 %0, %1, %2" : "=v"(r) : "v"(lo), "v"(hi)); return r;
}
__device__ __forceinline__ bf16x8 pack8(f32x4 a, f32x4 b) {
    u32x4 w = {cvtpk(a[0], a[1]), cvtpk(a[2], a[3]), cvtpk(b[0], b[1]), cvtpk(b[2], b[3])};
    return *reinterpret_cast<bf16x8*>(&w);
}
template <class T> __device__ __forceinline__ bf16x8 load8(const T* p) {
    if constexpr (same_t<T, float>::v) { return pack8(*(const f32x4*)p, *(const f32x4*)(p + 4)); }
    else { return *reinterpret_cast<const bf16x8*>(p); }
}
__device__ __forceinline__ void mask_tile(f32x16& p0, f32x16& p1, int dq, unsigned W) {
    const float NEG = -__builtin_inff();
#pragma unroll
    for (int r = 0; r < 16; ++r) {
        const int c = (r & 3) + 8 * (r >> 2);
        if ((unsigned)(dq - c) >= W) p0[r] = NEG;
        if ((unsigned)(dq - c - 32) >= W) p1[r] = NEG;
    }
}
__device__ __forceinline__ void partialSM(f32x16& p0, f32x16& p1, float& m_reg, float& mn, float& alpha) {
    float pmax = p0[0]; for (int r = 1; r < 16; ++r) pmax = fmaxf(pmax, p0[r]); for (int r = 0; r < 16; ++r) pmax = fmaxf(pmax, p1[r]);
    { auto rr = __builtin_amdgcn_permlane32_swap(__float_as_uint(pmax), __float_as_uint(pmax), false, false);
      pmax = fmaxf(__uint_as_float(rr[0]), __uint_as_float(rr[1])); }
    constexpr float C2 = 1.4426950408889634f * SCALE;
    if (__builtin_expect(__all((pmax - m_reg) * SCALE <= THR), 1)) { mn = m_reg; alpha = 1.f; }
    else { mn = fmaxf(m_reg, pmax); alpha = __builtin_amdgcn_exp2f((m_reg - mn) * C2); m_reg = mn; }
    const float mnL = -mn * C2;
    for (int r = 0; r < 16; ++r) p0[r] = fmaf(p0[r], C2, mnL); for (int r = 0; r < 16; ++r) p1[r] = fmaf(p1[r], C2, mnL);
    for (int r = 0; r < 16; ++r) p0[r] = __builtin_amdgcn_exp2f(p0[r]);
}
__device__ __forceinline__ void finishSM(f32x16& p0, f32x16& p1, float alpha, float& l_reg, bf16x8& pa0, bf16x8& pa1, bf16x8& pa2, bf16x8& pa3) {
    for (int r = 0; r < 16; ++r) p1[r] = __builtin_amdgcn_exp2f(p1[r]);
    float ps = 0; for (int r = 0; r < 16; ++r) ps += p0[r]; for (int r = 0; r < 16; ++r) ps += p1[r];
    { auto rr = __builtin_amdgcn_permlane32_swap(__float_as_uint(ps), __float_as_uint(ps), false, false);
      ps = __uint_as_float(rr[0]) + __uint_as_float(rr[1]); }
    l_reg = l_reg * alpha + ps;
#define PK4(P, B_, OUT) do { unsigned a0 = cvtpk(P[B_+0], P[B_+1]), a1 = cvtpk(P[B_+2], P[B_+3]);                          \
        unsigned b0 = cvtpk(P[B_+4], P[B_+5]), b1 = cvtpk(P[B_+6], P[B_+7]);                                             \
        auto r0 = __builtin_amdgcn_permlane32_swap(a0, b0, false, false); auto r1 = __builtin_amdgcn_permlane32_swap(a1, b1, false, false); \
        u32x4 w = {r0[0], r1[0], r0[1], r1[1]}; OUT = *reinterpret_cast<bf16x8*>(&w); } while (0)
    PK4(p0, 0, pa0); PK4(p0, 8, pa1); PK4(p1, 0, pa2); PK4(p1, 8, pa3);
#undef PK4
}
template <int KB, bool SK>
__device__ __forceinline__ void qkt(f32x16& p0, f32x16& p1, const char* K_lds, int r32, int hi, const bf16x8* qr, bool act, const float* bb) {
    if (SK && !act) { float NEG = -__builtin_inff(); asm volatile("" : "+v"(NEG));
#pragma unroll
        for (int r = 0; r < 16; ++r) { p0[r] = NEG; p1[r] = NEG; } return; }
    { const f32x4* b4 = (const f32x4*)(bb + 4 * hi);
#pragma unroll
      for (int g = 0; g < 4; ++g) { const f32x4 u0 = b4[2 * g], u1 = b4[8 + 2 * g];
          p0[4 * g] = u0[0]; p0[4 * g + 1] = u0[1]; p0[4 * g + 2] = u0[2]; p0[4 * g + 3] = u0[3];
          p1[4 * g] = u1[0]; p1[4 * g + 1] = u1[1]; p1[4 * g + 2] = u1[2]; p1[4 * g + 3] = u1[3]; } }
    const char* kb[4];
#pragma unroll
    for (int dd = 0; dd < 4; ++dd) kb[dd] = K_lds + KB * SHM_K + KSWZ(r32, (dd * 16 + hi * 8) * 2);
#pragma unroll
    for (int d0 = 0; d0 < 8; ++d0) { const char* a = kb[d0 & 3] + (d0 >> 2) * 128;
        bf16x8 b0 = *reinterpret_cast<const bf16x8*>(a);
        bf16x8 b1 = *reinterpret_cast<const bf16x8*>(a + 32 * 256);
        p0 = __builtin_amdgcn_mfma_f32_32x32x16_bf16(b0, qr[d0], p0, 0, 0, 0);
        p1 = __builtin_amdgcn_mfma_f32_32x32x16_bf16(b1, qr[d0], p1, 0, 0, 0); }
}
template <int VB, bool SK>
__device__ __forceinline__ void pv_tile(f32x16* o, int vb0, bf16x8 pa0, bf16x8 pa1, bf16x8 pa2, bf16x8 pa3, bool act) {
    if (SK && !act) return;
#define TRRD(dst, off) asm volatile("ds_read_b64_tr_b16 %0, %1 offset:%2" : "=&v"(dst) : "v"(vb0), "i"(off) : "memory")
#define PV_D0(d0) do { s16x4 l0, l1, l2, l3, h0, h1, h2, h3; constexpr int b_ = VB * SHM_V + v_rd_off(d0, 0, 0);     \
        TRRD(l0, b_); TRRD(h0, b_ + 2048); TRRD(l1, b_ + 4096); TRRD(h1, b_ + 6144); TRRD(l2, b_ + 8192); TRRD(h2, b_ + 10240); TRRD(l3, b_ + 12288); TRRD(h3, b_ + 14336); \
        asm volatile("s_waitcnt lgkmcnt(0)" ::: "memory"); SBAR();                 \
        o[d0] = __builtin_amdgcn_mfma_f32_32x32x16_bf16(pa0, (bf16x8){l0[0], l0[1], l0[2], l0[3], h0[0], h0[1], h0[2], h0[3]}, o[d0], 0, 0, 0);   \
        o[d0] = __builtin_amdgcn_mfma_f32_32x32x16_bf16(pa1, (bf16x8){l1[0], l1[1], l1[2], l1[3], h1[0], h1[1], h1[2], h1[3]}, o[d0], 0, 0, 0);   \
        o[d0] = __builtin_amdgcn_mfma_f32_32x32x16_bf16(pa2, (bf16x8){l2[0], l2[1], l2[2], l2[3], h2[0], h2[1], h2[2], h2[3]}, o[d0], 0, 0, 0);   \
        o[d0] = __builtin_amdgcn_mfma_f32_32x32x16_bf16(pa3, (bf16x8){l3[0], l3[1], l3[2], l3[3], h3[0], h3[1], h3[2], h3[3]}, o[d0], 0, 0, 0); } while (0)
    PV_D0(0); PV_D0(1); PV_D0(2); PV_D0(3);
#undef PV_D0
#undef TRRD
}

template <class TIn, class TOut> struct BlockRef { const TIn* Q; const TIn* K; const TIn* V; const TIn* K1; const TIn* V1; TOut* O; int P0, ksplit, nrows; };
template <class TIn> struct Seam {
    bf16x8 qr[8];
    bf16x8 st_v0, st_v1, st_k0, st_k1; f32x4 sf0, sf1, sf2, sf3;
    f32x4 tq[16];
};
__device__ __forceinline__ int swa_jlo(int P0, int W) { const int lowk = P0 - W + 1; return lowk > 0 ? lowk / KVBLK : 0; }
#define ROW(p, k0, rr) ((p) + (size_t)((k0) + (rr)) * LD + sc)
#define KSEL(k0) ((k0) >= cur.ksplit ? cur.K1 : cur.K)
#define VSEL(k0) ((k0) >= cur.ksplit ? cur.V1 : cur.V)
#define VMW() asm volatile("s_waitcnt vmcnt(0)" ::: "memory")
#define VMWN(n) asm volatile("s_waitcnt vmcnt(%0)" :: "i"(n) : "memory")
#define SLOAD_H(Kp, Vp, k0) do { S.st_v0 = load8<TIn>(ROW(Vp, k0, sr)); S.st_v1 = load8<TIn>(ROW(Vp, k0, 32 + sr));              \
                         S.st_k0 = load8<TIn>(ROW(Kp, k0, sr)); S.st_k1 = load8<TIn>(ROW(Kp, k0, 32 + sr)); } while (0)
#define SWRITE_HK(bf) do { *(bf16x8*)(K_lds + (bf) * SHM_K + kws) = S.st_k0; *(bf16x8*)(K_lds + (bf) * SHM_K + kws + 32 * 256) = S.st_k1; } while (0)
#define SWRITE_HV(bf) do { *(bf16x8*)(V_lds + (bf) * SHM_V + vst0) = S.st_v0; *(bf16x8*)(V_lds + (bf) * SHM_V + vst1) = S.st_v1; } while (0)
#define SWRITE_H(bf) do { SWRITE_HV(bf); SWRITE_HK(bf); } while (0)
#define SLOAD_F(p, k0) do { S.sf0 = *(const f32x4*)ROW(p, k0, sr); S.sf1 = *(const f32x4*)(ROW(p, k0, sr) + 4);                \
                            S.sf2 = *(const f32x4*)ROW(p, k0, 32 + sr); S.sf3 = *(const f32x4*)(ROW(p, k0, 32 + sr) + 4); } while (0)
#define SWRITE_KF(bf) do { *(bf16x8*)(K_lds + (bf) * SHM_K + kws) = pack8(S.sf0, S.sf1); *(bf16x8*)(K_lds + (bf) * SHM_K + kws + 32 * 256) = pack8(S.sf2, S.sf3); } while (0)
#define SWRITE_VF(bf) do { *(bf16x8*)(V_lds + (bf) * SHM_V + vst0) = pack8(S.sf0, S.sf1); *(bf16x8*)(V_lds + (bf) * SHM_V + vst1) = pack8(S.sf2, S.sf3); } while (0)
template <class TIn, class TOut>
__device__ __forceinline__ void causal_swa_prime(const BlockRef<TIn, TOut>& cur, int W, char* lds, Seam<TIn>& S) {
    constexpr bool F32 = same_t<TIn, float>::v;
    const int tid = opaque_tid(), wid = __builtin_amdgcn_readfirstlane(tid >> 6), lane = tid & 63, r32 = lane & 31, hi = lane >> 5;
    const int sr = tid >> 4, sc = (tid & 15) * 8, kws = KSWZ(sr, sc * 2); char* K_lds = lds + 2 * SHM_V;
    const int kb0 = swa_jlo(cur.P0, W) * KVBLK;
    for (int d0 = 0; d0 < 8; ++d0) S.qr[d0] = load8<TIn>(cur.Q + (size_t)(wid * QBLK + r32) * LD + d0 * 16 + hi * 8);
    if constexpr (F32) { SLOAD_F((const float*)cur.K, kb0); VMW(); SWRITE_KF(0); SBAR(); SLOAD_F((const float*)cur.V, kb0); }
    else { SLOAD_H(cur.K, cur.V, kb0); VMW(); SWRITE_HK(0); }
    __syncthreads();
}
template <class TIn, class TOut>
__device__ __forceinline__ void causal_swa_block(const BlockRef<TIn, TOut>& cur, const BlockRef<TIn, TOut>& nxt, int skv, int W, char* lds, Seam<TIn>& S) {
    constexpr bool F32 = same_t<TIn, float>::v;
    const int tid = opaque_tid(), wid = __builtin_amdgcn_readfirstlane(tid >> 6), lane = tid & 63, r32 = lane & 31, hi = lane >> 5;
    const int j_lo = swa_jlo(cur.P0, W);
    int j_hi = (cur.P0 + QB - 1) / KVBLK + 1; if (j_hi > skv / KVBLK) j_hi = skv / KVBLK;
    const int NT = j_hi - j_lo;
    const int kbn = swa_jlo(nxt.P0, W) * KVBLK;
    const int qlo = cur.P0 + wid * QBLK, qm = qlo + r32 - 4 * hi;
    char* V_lds = lds; char* K_lds = lds + 2 * SHM_V;
    float* ws = (float*)(lds + 2 * SHM_V + 2 * SHM_K) + wid * 64; float* li_l = ws, * al_l = ws + 32;
    float m_reg = -1e30f, l_reg = 0; f32x16 o[4] = {};
    const int sr = tid >> 4, sc = (tid & 15) * 8, vst0 = v_st(sr, sc), vst1 = v_st(32 + sr, sc), kws = KSWZ(sr, sc * 2);
    const int vb0 = (int)(uintptr_t)V_lds + v_rd_base(lane);
    const float* bl = (const float*)(lds + OFF_BIAS);
#define RESC(a) do { if (__any((a) < 1.f)) { if (hi == 0) al_l[r32] = (a); asm volatile("s_waitcnt lgkmcnt(0)" ::: "memory");              \
                     for (int d_ = 0; d_ < 4; ++d_) for (int r = 0; r < 16; ++r) o[d_][r] *= al_l[crow(r, hi)]; } } while (0)
#define KBASE(t) ((j_lo + (t)) * KVBLK)
#define ACT(t) (wvalid && KBASE(t) <= qlo + QBLK - 1 && KBASE(t) + KVBLK - 1 >= qlo - W + 1)
#define MASKT(P0_, P1_, t) do { const int kb_ = KBASE(t); if ((!SK || ACT(t)) && (kb_ + KVBLK - 1 > qlo || kb_ <= qlo + QBLK - 1 - W)) mask_tile(P0_, P1_, qm - kb_, (unsigned)W); } while (0)
    constexpr int NQL = F32 ? 16 : 8;
    constexpr bool SK = F32;
    const bool wvalid = wid * QBLK < cur.nrows;
#define WV (!SK || wvalid)
#define SEAM_K0() do { VMWN(NQL); if constexpr (F32) { SWRITE_KF(0); SBAR(); SLOAD_F((const float*)nxt.V, kbn); } else { SWRITE_HK(0); } SBAR(); } while (0)
    f32x16 pA0, pA1, pB0, pB1; float mnA, mnB, alA, alB; bf16x8 pa0, pa1, pa2, pa3;
    if constexpr (F32) { VMW(); SWRITE_VF(0); SBAR(); } else { SWRITE_HV(0); SBAR(); }
    if (NT > 1) { if constexpr (F32) SLOAD_F((const float*)KSEL(KBASE(1)), KBASE(1)); else SLOAD_H(KSEL(KBASE(1)), VSEL(KBASE(1)), KBASE(1)); }
    SBAR(); qkt<0, SK>(pA0, pA1, K_lds, r32, hi, S.qr, ACT(0), bl + KBASE(0));
    if constexpr (F32) { if (NT > 1) { VMW(); SWRITE_KF(1); SBAR(); SLOAD_F((const float*)VSEL(KBASE(1)), KBASE(1)); } }
    if (WV) { MASKT(pA0, pA1, 0); partialSM(pA0, pA1, m_reg, mnA, alA); }
    if (NT > 1) { VMW(); if constexpr (F32) { SWRITE_VF(1); SBAR(); if (NT > 2) SLOAD_F((const float*)KSEL(KBASE(2)), KBASE(2)); } else SWRITE_H(1); }
    __syncthreads();
#define HALF_STEP(PX0, PX1, mnX, alX, PY0, PY1, alY, t, KB, VB, SB) do {                                                      \
        SBAR(); qkt<KB, SK>(PX0, PX1, K_lds, r32, hi, S.qr, ACT(t), bl + KBASE(t));                                             \
        if (WV) finishSM(PY0, PY1, alY, l_reg, pa0, pa1, pa2, pa3); SBAR();                                                   \
        if ((t) + 1 < NT) { if constexpr (F32) { VMW(); SWRITE_KF(SB); SBAR(); SLOAD_F((const float*)VSEL(KBASE((t) + 1)), KBASE((t) + 1)); }  \
                            else { SLOAD_H(KSEL(KBASE((t) + 1)), VSEL(KBASE((t) + 1)), KBASE((t) + 1)); } SBAR(); }                                               \
        pv_tile<VB, SK>(o, vb0, pa0, pa1, pa2, pa3, ACT((t) - 1)); if (WV) { MASKT(PX0, PX1, (t)); partialSM(PX0, PX1, m_reg, mnX, alX); }                                        \
        __syncthreads();                                                                                                      \
        if ((t) + 1 < NT) { VMW(); if constexpr (F32) { SWRITE_VF(SB); SBAR(); if ((t) + 2 < NT) SLOAD_F((const float*)KSEL(KBASE((t) + 2)), KBASE((t) + 2)); } \
                            else { SWRITE_H(SB); } }                                                                          \
        if (WV) RESC(alX); __syncthreads(); } while (0)
    for (int t = 1; t + 1 < NT; t += 2) {
        HALF_STEP(pB0, pB1, mnB, alB, pA0, pA1, alA, t, 1, 0, 0);
        HALF_STEP(pA0, pA1, mnA, alA, pB0, pB1, alB, t + 1, 0, 1, 1);
    }
    const bool even = (NT & 1) == 0;
    if (even) { SBAR(); qkt<1, SK>(pB0, pB1, K_lds, r32, hi, S.qr, ACT(NT - 1), bl + KBASE(NT - 1)); SBAR(); }
    SBAR();
    if (WV) finishSM(pA0, pA1, alA, l_reg, pa0, pa1, pa2, pa3); SBAR();
    pv_tile<0, SK>(o, vb0, pa0, pa1, pa2, pa3, ACT(even ? NT - 2 : NT - 1));
    if (even) { if (WV) { MASKT(pB0, pB1, NT - 1); partialSM(pB0, pB1, m_reg, mnB, alB); } __syncthreads(); if (WV) { RESC(alB);
        finishSM(pB0, pB1, alB, l_reg, pa0, pa1, pa2, pa3); } SBAR(); pv_tile<1, SK>(o, vb0, pa0, pa1, pa2, pa3, ACT(NT - 1)); }
    SBAR();
    if (hi == 0) li_l[r32] = l_reg; asm volatile("s_waitcnt lgkmcnt(0)" ::: "memory");
    float rli[16];
#pragma unroll
    for (int r = 0; r < 16; ++r) rli[r] = __builtin_amdgcn_rcpf(li_l[crow(r, hi)]);
    TOut* Ow = cur.O + (size_t)(wid * QBLK) * LDO; if (wid * QBLK < cur.nrows) {
#pragma unroll
    for (int r = 0; r < 16; ++r) { const int orow = crow(r, hi);
#pragma unroll
        for (int d0 = 0; d0 < 4; ++d0) { const float v = o[d0][r] * rli[r];
            if constexpr (same_t<TOut, float>::v) { Ow[(size_t)orow * LDO + d0 * 32 + r32] = v; }
            else { const float vn = shfl_xor_f(v, 1);
                   if ((r32 & 1) == 0) *(unsigned*)(Ow + (size_t)orow * LDO + d0 * 32 + r32) = cvtpk(v, vn); } } } }
    __syncthreads();
#undef RESC
#undef WV
#undef KBASE
#undef ACT
#undef MASKT
#undef SEAM_K0
#undef HALF_STEP
}
#undef ROW
#undef KSEL
#undef VSEL
#undef VMW
#undef VMWN
#undef SLOAD_H
#undef SWRITE_HK
#undef SWRITE_HV
#undef SWRITE_H
#undef SLOAD_F
#undef SWRITE_KF
#undef SWRITE_VF
#undef KSWZ
#undef SBAR
}
DI void fox_bias(char* lds, const float* lf0, int n0, const float* lf1, int n1) {
    const int tid = opaque_tid(), lane = tid & 63, wave = tid >> 6, n = n0 + n1;
    float* bias = (float*)(lds + fa::OFF_BIAS);
    double* wt = (double*)(lds + 2 * fa::SHM_V + 2 * fa::SHM_K);
    double v[8]; double s = 0.0;
#pragma unroll
    for (int k = 0; k < 8; ++k) { const int t = 8 * tid + k; float x = 0.f; if (t < n0) x = lf0[(size_t)8 * t]; else if (t < n) x = lf1[(size_t)8 * (t - n0)]; s += (double)x; v[k] = s; }
    double inc = s;
#pragma unroll
    for (int o = 1; o < 64; o <<= 1) { const double y = shfl_up_d(inc, o); if (lane >= o) inc += y; }
    if (lane == 63) wt[wave] = inc;
    __syncthreads();
    double off = inc - s;
    for (int k = 0; k < wave; ++k) off += wt[k];
#pragma unroll
    for (int k = 0; k < 8; ++k) { const int t = 8 * tid + k; if (t < n) bias[t] = (float)(-(v[k] + off) * 11.313708498984761); }
    __syncthreads();
}

DI void pool_diff_phase(CP& P, int o, int layer, const u64* ss, const bf16_t* X) {
    const int tid = opaque_tid(), blk = blockIdx.x;
    bf16_t* DIFF = (bf16_t*)(P.ws + WS_MIXA);
    const int c0 = tid * 4, grp = c0 >> 9, w = 2 << grp;
    const f32x4 g = *(const f32x4*)(P.norm_mix + (size_t)layer * DM + c0);
#define XROW(m) ({ const u32x2 q_ = *(const u32x2*)(X + (size_t)(m) * DM + c0); (f32x4){__uint_as_float(q_.x << 16), __uint_as_float(q_.x & 0xffff0000u), __uint_as_float(q_.y << 16), __uint_as_float(q_.y & 0xffff0000u)}; })
    for (int st = blk; st < M / 32; st += NBLK) {
        const int m0 = st * 32; const bool prompt = m0 < MP;
        const int seq0 = prompt ? (m0 & ~(SEQ - 1)) : MP + ((m0 - MP) & ~(SSEQ - 1));
        const int T = prompt ? SEQ : SSEQ, b = prompt ? m0 / SEQ : (m0 - MP) / SSEQ;
        const float* sp = P.state_pool + ((size_t)o * NB_S + b) * PBUF * DM + c0;
        float* po = prompt ? P.out + O_PP + ((size_t)o * NB_P + b) * PBUF * DM + c0 : P.out + O_PS + ((size_t)o * NB_S + b) * PBUF * DM + c0;
#define HROW(m) ((m) >= seq0 ? (XROW(m) * (rs_of(ss, (m)) ) * g) : (prompt ? (f32x4){0.f, 0.f, 0.f, 0.f} : *(const f32x4*)(sp + (size_t)(PBUF + (m) - seq0) * DM)))
        f32x4 S = {0.f, 0.f, 0.f, 0.f};
        for (int k = 1; k < w; ++k) { const int m = m0 - k; S += HROW(m); }
        for (int t = m0; t < m0 + 32; ++t) {
            const f32x4 h = XROW(t) * rs_of(ss, t) * g;
            S += h;
            const int pos = t - seq0; const int cnt = prompt ? (pos + 1 < w ? pos + 1 : w) : w;
            const f32x4 d = S * (1.0f / (float)cnt) - h;
            u32x2 pk; pk.x = cvt_pk_bf16(d[0], d[1]); pk.y = cvt_pk_bf16(d[2], d[3]);
            *(u32x2*)(DIFF + (size_t)t * DM + c0) = pk;
            if (pos >= T - PBUF) *(f32x4*)(po + (size_t)(pos - (T - PBUF)) * DM) = h;
            const int mo = t - w + 1; S -= HROW(mo);
        }
#undef HROW
    }
#undef XROW
}

DI void final_norm_phase(CP& P, const u64* ss, const bf16_t* X) {
    const int tid = opaque_tid(), lane = tid & 63, wave = tid >> 6, blk = blockIdx.x;
    for (int m = blk * 8 + wave; m < M; m += NBLK * 8) {
        const float rs = rs_of(ss, m);
#pragma unroll
        for (int j = 0; j < 4; ++j) { const int c = j * 512 + lane * 8; f32x4 a, b; unpack8(*(const u32x4*)(X + (size_t)m * DM + c), a, b);
            *(f32x4*)(P.out + O_YP + (size_t)m * DM + c) = a * rs * *(const f32x4*)(P.final_norm + c);
            *(f32x4*)(P.out + O_YP + (size_t)m * DM + c + 4) = b * rs * *(const f32x4*)(P.final_norm + c + 4); }
    }
}

DI int dequeue(unsigned* head, volatile LAS unsigned* slot) {
    if (threadIdx.x == 0) *slot = __hip_atomic_fetch_add(head, 1u, __ATOMIC_RELAXED, __HIP_MEMORY_SCOPE_AGENT);
    LDS_BARRIER();
    const int v = (int)*slot;
    LDS_BARRIER();
    return v;
}

DI void warm_weights(const void* p, size_t bytes) {
    const size_t gt = (size_t)blockIdx.x * NTHR + opaque_tid();
    const char* b = (const char*)p;
    for (size_t o = gt * 16; o < bytes; o += (size_t)NBLK * NTHR * 16) { u32x4 d; asm volatile("global_load_dwordx4 %0, %1, off" : "=v"(d) : "v"(b + o) : "memory"); }
    asm volatile("s_waitcnt vmcnt(0)" ::: "memory");
}

template <int MODE>
DI void splitk_reduce(const pg8::StaticOrder& S, const EpiRes<MODE>& E) {
    const int tid = opaque_tid(), lane = tid & 63, wave = tid >> 6;
    const int nf = S.nfull(), nl = S.nwg - nf;
    for (int r = blockIdx.x * 8 + wave; r < nl * 256; r += gridDim.x * 8) {
        const int li = r >> 8, rl = r & 255;
        pg8::Unit u; S.tile_of(nf + li, u);
        const int row = u.pm * 256 + rl, col = u.pn * 256 + lane * 4;
        const float* sp = E.slab + (size_t)(li * 4) * 65536 + (size_t)rl * 256 + lane * 4;
        f32x4 v = (*(const f32x4*)sp + *(const f32x4*)(sp + 65536)) + (*(const f32x4*)(sp + 2 * 65536) + *(const f32x4*)(sp + 3 * 65536));
        const u32x2 xq = *(const u32x2*)(E.xold + (size_t)row * DM + col);
        f32x4 o = {__uint_as_float(xq.x << 16), __uint_as_float(xq.x & 0xffff0000u), __uint_as_float(xq.y << 16), __uint_as_float(xq.y & 0xffff0000u)};
        if (MODE == 1) { const float rs = rs_of(E.ss_in, row); const u32x2 q = *(const u32x2*)(E.pp + (size_t)row * DM + col);
            const f32x4 p = {__uint_as_float(q.x << 16), __uint_as_float(q.x & 0xffff0000u), __uint_as_float(q.y << 16), __uint_as_float(q.y & 0xffff0000u)};
#pragma unroll
            for (int j = 0; j < 4; ++j) v[j] = fsigm(v[j] * rs) * p[j]; }
        o += v;
        u32x2 pk; pk.x = cvt_pk_bf16(o[0], o[1]); pk.y = cvt_pk_bf16(o[2], o[3]);
        *(u32x2*)(E.xb + (size_t)row * DM + col) = pk;
        const float s = wave_sum((o[0] * o[0] + o[1] * o[1]) + (o[2] * o[2] + o[3] * o[3]));
        if (lane == 0) __hip_atomic_fetch_add(E.ssq_out + row, ss_fix(s), __ATOMIC_RELAXED, __HIP_MEMORY_SCOPE_AGENT);
    }
}

constexpr int PH_PRO = 0, PH_PP = 1, PH_L0 = 2, PH_PER_PAIR = 19, PH_FINAL = PH_L0 + 2 * PH_PER_PAIR, NPHASES = PH_FINAL + 1;

__global__ void __launch_bounds__(NTHR, 2) mk_fwd(Params Pv) {
    (void)Pv; CP* const kp = (CP*)__builtin_amdgcn_kernarg_segment_ptr();
#define P (*launder_cp(kp))
    extern __shared__ __attribute__((aligned(16))) unsigned char lds_raw[];
    LAS unsigned char* lds = (LAS unsigned char*)lds_raw;
    volatile LAS unsigned* MISC = (volatile LAS unsigned*)(lds + LDS_MISC);
    const int tid = opaque_tid(), blk = blockIdx.x, G = gridDim.x;
    unsigned* ctl = (unsigned*)(P.ws + WS_CTL);
    if (tid < 64) MISC[tid] = 0u;
    __syncthreads();
    XcdBarrier bar = xcd_barrier_post(ctl + CW_BAR, MISC + 8);
    const int lo = P.ph_lo, hi = P.ph_hi;
#ifndef DBG_MASK
#define DBG_MASK 0xffffffffu
#endif
#define IN(k) (lo <= (k) && (k) < hi)
#define INP(j) (((DBG_MASK >> (j)) & 1u) && IN(pb + (j)))
#define ING(k, bit) (((DBG_MASK >> (bit)) & 1u) && IN(k))
#ifndef PROBE_BAR2
#define PROBE_BAR2 0
#endif
#define SEAM(k) do { if (IN(k) && IN((k) + 1)) { xcd_barrier(bar); if (PROBE_BAR2) { xcd_barrier(bar); xcd_barrier(bar); } } } while (0)
#ifndef REP_MASK
#define REP_MASK 0u
#endif
#define NREP(bit) ((((REP_MASK) >> (bit)) & 1u) ? 2 : 1)
#ifndef E1_ROT
#define E1_ROT 17
#endif
#ifndef FILL_ON
#define FILL_ON 0
#endif
#ifndef FILL_GEMM
#define FILL_GEMM 0
#endif
#ifndef FILL_E2_FIRST
#define FILL_E2_FIRST 192
#endif
#ifndef FILL_BUDGET
#define FILL_BUDGET 10
#endif
#ifndef WARM_ON
#define WARM_ON 0
#endif
#ifndef PROBE_M0
#define PROBE_M0 0
#endif
#ifndef PROBE_NOMMA
#define PROBE_NOMMA 0
#endif
#ifndef SPLIT_O2
#define SPLIT_O2 2
#endif
#ifndef E3_MERGE
#define E3_MERGE 1
#endif
#ifndef SPLIT_F2
#define SPLIT_F2 1
#endif
#ifndef SPLIT_G1
#define SPLIT_G1 2
#endif
#ifndef SPLIT_TAIL
#define SPLIT_TAIL 1
#endif
#define REPEAT(bit) for (int rep = 0; rep < NREP(bit); ++rep, ((rep < NREP(bit)) ? xcd_barrier(bar) : (void)0))
#define DUMMY(bit) (rep + 1 < NREP(bit))

#define SS ((u64*)(P.ws + WS_SS))
#define XB0 ((bf16_t*)(P.ws + WS_XB0))
#define XB1 ((bf16_t*)(P.ws + WS_XB1))
#define MIXA ((bf16_t*)(P.ws + WS_MIXA))
#define ACT ((bf16_t*)(P.ws + WS_ACT))
#define QR ((bf16_t*)(P.ws + WS_QR))
#define QD ((bf16_t*)(P.ws + WS_QD))
#define KR ((bf16_t*)(P.ws + WS_KR))
#define KD ((bf16_t*)(P.ws + WS_KD))
#define VR ((bf16_t*)(P.ws + WS_VR))
#define GR ((bf16_t*)(P.ws + WS_GR))
#define QF ((bf16_t*)(P.ws + WS_QF))
#define KF ((bf16_t*)(P.ws + WS_KF))
#define VF ((bf16_t*)(P.ws + WS_VF))
#define QS32 ((float*)(P.ws + WS_QS32))
#define SPREV ((bf16_t*)(P.ws + WS_SPREV))

    if (ING(PH_PRO, 20)) REPEAT(20) { prologue(P, lds); }
    SEAM(PH_PRO);

#define RES_PHASES(J, MODE, SPL, AOP, LDA, BOP, LDB, KK, XOLD, XBO, SLOT_OUT, SLOT_IN, PPI, FILLB, DRAINL) \
    if (INP(J)) REPEAT(J) { \
        pg8::StaticOrder S; S.init(M, DM, launder_i(G), launder_i(blk), AOP, BOP, LDA, LDB, KK); S.split = (SPL); if (PROBE_NOMMA && DUMMY(J)) S.nomma = PROBE_NOMMA; \
        if (PROBE_M0 == 2 && DUMMY(J)) { EpiNull EN{(float*)(P.ws + WS_XDUM)}; pg8::gemm_phase<EpiNull, pg8::StaticOrder>(lds, pg8::Gemm{LDA, LDB, KK}, S, EN); } else \
        if (PROBE_M0 == 1 && MODE == 1 && DUMMY(J)) { EpiRes<0> E0{XOLD, (bf16_t*)(P.ws + WS_XBDUM), SS + (size_t)14 * M, SS, nullptr, (float*)(P.ws + WS_SLAB)}; \
            pg8::gemm_phase<EpiRes<0>, pg8::StaticOrder>(lds, pg8::Gemm{LDA, LDB, KK}, S, E0); } else { \
        EpiRes<MODE> E{XOLD, DUMMY(J) ? (bf16_t*)(P.ws + WS_XBDUM) : XBO, DUMMY(J) ? SS + (size_t)14 * M : SS + (size_t)(SLOT_OUT) * M, SS + (size_t)(SLOT_IN) * M, PPI, (SPL) == 2 ? nullptr : (float*)(P.ws + WS_SLAB)}; \
        pg8::gemm_phase<EpiRes<MODE>, pg8::StaticOrder, PG8_ALIGN, (SPL) == 2>(lds, pg8::Gemm{LDA, LDB, KK}, S, E); } \
        if (FILL_ON && FILL_GEMM && !(SPL) && blk >= 64) convert_fill(P, lds, ctl + CW_Q + 64 * 8, MISC + 17, NREST, FILLB);     \
        if (FILL_ON && (DRAINL) > 0) convert_fill(P, lds, ctl + CW_Q + 64 * 8, MISC + 17, (DRAINL), 1 << 30);       \
    } \
    SEAM(pb + (J)); \
    if (INP((J) + 1) && (SPL) == 1) { \
        pg8::StaticOrder S; S.init(M, DM, launder_i(G), launder_i(blk), AOP, BOP, LDA, LDB, KK); S.split = (SPL); \
        EpiRes<MODE> E{XOLD, XBO, SS + (size_t)(SLOT_OUT) * M, SS + (size_t)(SLOT_IN) * M, PPI, (float*)(P.ws + WS_SLAB)}; \
        splitk_reduce<MODE>(S, E); \
    } \
    if ((SPL) == 1) SEAM(pb + (J) + 1);
#define FFN_PLE_PHASES(J, XBA, XBB) \
    if (INP(J)) REPEAT(J) {     \
        pg8::StaticOrder S; S.init(M, 2 * DFF, launder_i(G), launder_i(blk), XBA, (const bf16_t*)(P.ws + WS_WGU) + (size_t)i * 2 * DFF * DM, DM, DM, DM); \
        if (PROBE_NOMMA && DUMMY(J)) S.nomma = PROBE_NOMMA; \
        EpiAct E{SS + (size_t)(3 * i + 1) * M, ACT}; \
        pg8::gemm_phase<EpiAct, pg8::StaticOrder>(lds, pg8::Gemm{DM, DM, DM}, S, E); \
    } \
    SEAM(pb + (J)); \
    RES_PHASES((J) + 1, 0, SPLIT_F2, ACT, LDF, (const bf16_t*)(P.ws + WS_WDN) + (size_t)i * DM * LDF, LDF, DFF, XBA, XBB, 3 * i + 2, 0, nullptr, 0, 0)     \
    RES_PHASES((J) + 3, 1, SPLIT_G1, XBB, DM, (const bf16_t*)(P.ws + WS_WPG) + (size_t)i * DM * DM, DM, DM, XBB, XBA, 3 * i + 3, 3 * i + 2, (const bf16_t*)(P.ws + WS_PPJ) + (size_t)i * M * DM, FILL_BUDGET, (i == 1) ? QL2 : (i == 2) ? NREST : 0)

#pragma unroll 1
    for (int lp = 0; lp < 2; ++lp) {
        const int pb = PH_L0 + lp * PH_PER_PAIR;
        {
            const int i = 2 * lp, e = lp;
#define oKs (P.out + O_KS + (size_t)e * MS * FW)
#define oVs (P.out + O_VS + (size_t)e * MS * FW)
            if (INP(0)) REPEAT(0) {
                pg8::StaticOrder S; S.init(M, INW_P, launder_i(G), launder_i(blk), XB0, (const bf16_t*)(P.ws + WS_WIN) + (size_t)e * INW_P * DM, DM, DM, DM);
                S.rot = E1_ROT;
                if (PROBE_M0 == 2 && DUMMY(0)) { EpiNull EN{(float*)(P.ws + WS_XDUM)}; pg8::gemm_phase<EpiNull, pg8::StaticOrder>(lds, pg8::Gemm{DM, DM, DM}, S, EN); } else {
                EpiIn E{P.ws, P.out, e, 3 * i};
                pg8::gemm_phase<EpiIn, pg8::StaticOrder>(lds, pg8::Gemm{DM, DM, DM}, S, E); }
                if (lp == 0 && ((DBG_MASK >> 21) & 1u) && blk >= 96) {
                    pg8::StaticOrder S2; S2.init(4 * M, DM, 160, launder_i(blk) - 96, (const bf16_t*)(P.ws + WS_PB), (const bf16_t*)(P.ws + WS_WPP), PLE, PLE, PLE); S2.b_mgrp = M / 256; S2.b_mrows = DM;
                    EpiBf E2{(bf16_t*)(P.ws + WS_PPJ), DM};
                    pg8::gemm_phase<EpiBf, pg8::StaticOrder>(lds, pg8::Gemm{PLE, PLE, PLE}, S2, E2);
                }
                if (i == 0) fgate_units<float>(P, lds, e, P.x_p, P.x_s, SS + (size_t)(3 * i) * M); else fgate_units<bf16_t>(P, lds, e, XB0, XB0 + (size_t)MP * DM, SS + (size_t)(3 * i) * M);
                if (FILL_ON && FILL_GEMM && lp == 1 && blk >= 96) convert_fill(P, lds, ctl + CW_Q + 64 * 8, MISC + 17, NREST, FILL_BUDGET);
            }
            SEAM(pb + 0);
            if (INP(1)) REPEAT(1) {
                if (FILL_ON && blk >= FILL_E2_FIRST) convert_fill(P, lds, ctl + CW_Q + 64 * 8, MISC + 17, lp == 0 ? QL2 : NREST, 1 << 30);
                unsigned* head = ctl + CW_Q + 64 * (e + 2 * rep);
                unsigned* dep = ctl + CW_DEP + 64 * 8 * (e + 2 * rep);
                for (;;) {
                    const int L = __builtin_amdgcn_readfirstlane(dequeue(head, MISC + 16));
                    if (L >= 64 + 512 + 128 + E3_MERGE * 512) break;
                    if (L < 64) { if ((DBG_MASK >> 24) & 1u) { rt::ab_unit(lds, L >> 3, L & 7, KD, VR, SPREV, P.out + O_RSP + (size_t)e * NB_P * HR * 65536);
                            if (E3_MERGE) { asm volatile("s_waitcnt vmcnt(0)" ::: "memory"); __syncthreads();
                                if (opaque_tid() == 0) { __builtin_amdgcn_fence(__ATOMIC_RELEASE, "agent"); asm volatile("s_waitcnt vmcnt(0)" ::: "memory"); (void)xb_add(dep + 64 * (L >> 3), 1u); } } }
                        continue; }
                    if (L >= 704) { if ((DBG_MASK >> 27) & 1u) { const int u = L - 704, bh = u >> 6, c = u & 63, b = bh >> 2, h = bh & 3;
                            if (opaque_tid() == 0) { XB_SPIN(xb_ld(dep + 64 * bh) < 8u, ctl + CW_BAR); __builtin_amdgcn_fence(__ATOMIC_ACQUIRE, "agent"); asm volatile("s_waitcnt vmcnt(0)" ::: "memory"); }
                            __syncthreads();
                            rt::c_unit<false>(lds, b * SEQ + c * 64, h, QR, QD, KR, KD, VR, GR, SPREV + ((size_t)bh * 64 + c) * 65536, nullptr, MIXA); }
                        continue; }
                    if (L >= 576) { if ((DBG_MASK >> 25) & 1u) { const int u = L - 576, b = u >> 2, h = u & 3; const size_t so = ((size_t)(e * NB_S + b) * HR + h) * 65536;
                        rt::c_unit<true>(lds, MP + b * SSEQ, h, QR, QD, KR, KD, VR, GR, P.state_ret + so, P.out + O_RSS + so, MIXA); } continue; }
                    if (!((DBG_MASK >> 26) & 1u)) continue;
                    const int Lq = L - 64;
                    const int QU = (Lq >= 32 && Lq < 288) ? Lq - 32 : -1, QP = Lq < 32 ? Lq : Lq - 256;
                    if (QU >= 0) {
                        const int u = QU, b = u >> 3, h = u & 7;
                        fox_bias((char*)lds_raw, P.cache_lf + ((size_t)(e * NB_S + b) * PAST) * HF + h, PAST, P.out + O_LS + ((size_t)e * MS + (size_t)b * SSEQ) * HF + h, SSEQ);
                        fa::BlockRef<float, bf16_t> cur;
                        cur.Q = QS32 + (size_t)b * SSEQ * FW + h * DHF;
                        cur.K = P.cache_k + ((size_t)(e * NB_S + b) * PAST) * FW + h * DHF; cur.V = P.cache_v + ((size_t)(e * NB_S + b) * PAST) * FW + h * DHF;
                        cur.K1 = oKs + (size_t)b * SSEQ * FW + h * DHF - (size_t)PAST * FW; cur.V1 = oVs + (size_t)b * SSEQ * FW + h * DHF - (size_t)PAST * FW;
                        cur.O = MIXA + ((size_t)MP + (size_t)b * SSEQ) * DM + RW + h * DHF; cur.P0 = PAST; cur.ksplit = PAST; cur.nrows = SSEQ;
                        fa::Seam<float> Sm;
                        fa::causal_swa_prime<float, bf16_t>(cur, 1 << 30, (char*)lds_raw, Sm);
                        fa::causal_swa_block<float, bf16_t>(cur, cur, PAST + SSEQ, 1 << 30, (char*)lds_raw, Sm);
                    } else {
                        const int Lp = QP;
                        const int qb = 15 - (Lp >> 4), bh = Lp & 15, b = bh >> 3, h = bh & 7;
                        fox_bias((char*)lds_raw, P.out + O_LP + ((size_t)e * MP + (size_t)b * SEQ) * HF + h, SEQ, nullptr, 0);
                        fa::BlockRef<bf16_t, bf16_t> cur;
                        cur.Q = QF + ((size_t)b * SEQ + (size_t)qb * 256) * FW + h * DHF; cur.K = KF + (size_t)b * SEQ * FW + h * DHF; cur.V = VF + (size_t)b * SEQ * FW + h * DHF;
                        cur.K1 = cur.K; cur.V1 = cur.V; cur.O = MIXA + ((size_t)b * SEQ + (size_t)qb * 256) * DM + RW + h * DHF; cur.P0 = qb * 256; cur.ksplit = 1 << 30; cur.nrows = 256;
                        fa::Seam<bf16_t> Sm;
                        fa::causal_swa_prime<bf16_t, bf16_t>(cur, 1 << 30, (char*)lds_raw, Sm);
                        fa::causal_swa_block<bf16_t, bf16_t>(cur, cur, SEQ, 1 << 30, (char*)lds_raw, Sm);
                    }
                }
            }
            SEAM(pb + 1);
            if (!E3_MERGE && INP(2)) REPEAT(2) {
                if ((DBG_MASK >> 27) & 1u) for (int u = blk; u < 512; u += G) { const int bh = u >> 6, c = u & 63, b = bh >> 2, h = bh & 3;
                    rt::c_unit<false>(lds, b * SEQ + c * 64, h, QR, QD, KR, KD, VR, GR, SPREV + ((size_t)bh * 64 + c) * 65536, nullptr, MIXA); }
            }
            if (!E3_MERGE) SEAM(pb + 2);
            RES_PHASES(3, 0, SPLIT_G1, MIXA, MIXW, (const bf16_t*)(P.ws + WS_WOUT) + (size_t)e * DM * MIXW, MIXW, MIXW, XB0, XB1, 3 * i + 1, 0, nullptr, FILL_BUDGET, (i == 2) ? QL3 : 0)
            FFN_PLE_PHASES(5, XB1, XB0)
        }
        {
            const int i = 2 * lp + 1, o = lp;
            if (INP(10)) REPEAT(10) pool_diff_phase(P, o, i, SS + (size_t)(3 * i) * M, XB1);
            SEAM(pb + 10);
            if (INP(11)) REPEAT(11) {
                pg8::StaticOrder S; S.init(M, DM, launder_i(G), launder_i(blk), MIXA, (const bf16_t*)(P.ws + WS_WPL) + (size_t)o * DM * 512, DM, 512, 512); S.a_kgrp = 512; S.a_kgrp_div = 2; S.split = SPLIT_O2;
                EpiRes<0> E{XB1, DUMMY(11) ? (bf16_t*)(P.ws + WS_XBDUM) : XB0, DUMMY(11) ? SS + (size_t)14 * M : SS + (size_t)(3 * i + 1) * M, nullptr, nullptr, nullptr};
                pg8::gemm_phase<EpiRes<0>, pg8::StaticOrder, PG8_ALIGN, SPLIT_O2 == 2>(lds, pg8::Gemm{DM, 512, 512}, S, E);
                if (FILL_ON && FILL_GEMM && blk >= 64) convert_fill(P, lds, ctl + CW_Q + 64 * 8, MISC + 17, NREST, FILL_BUDGET / 2);
                if (FILL_ON && i == 1) convert_fill(P, lds, ctl + CW_Q + 64 * 8, MISC + 17, QL1, 1 << 30);
            }
            SEAM(pb + 11);
            FFN_PLE_PHASES(12, XB0, XB1)
        }
    }
    if (ING(PH_FINAL, 22)) REPEAT(22) final_norm_phase(P, SS + (size_t)12 * M, XB0);
#undef RES_PHASES
#undef FFN_PLE_PHASES
#undef IN
#undef P
#undef SS
#undef XB0
#undef XB1
#undef MIXA
#undef ACT
#undef QR
#undef QD
#undef KR
#undef KD
#undef VR
#undef GR
#undef QF
#undef KF
#undef VF
#undef QS32
#undef SPREV
#undef oKs
#undef oVs
#undef INP
#undef ING
#undef SEAM
}

extern "C" void kernel_launch(void* const* d_in, const int* in_sizes, int n_in, void* d_out, int out_size, void* d_ws, size_t ws_size, hipStream_t stream) {
    static int ready = 0;
    if (ready == 0) {
        ready = -1;
        if (n_in != 23 || (size_t)out_size != O_END || ws_size < WS_END) { fprintf(stderr, "kernel_launch: unexpected shapes (n_in %d, out %d, ws %zu; need 23, %zu, >= %zu)\n", n_in, out_size, ws_size, (size_t)O_END, (size_t)WS_END); return; }
        if (hipFuncSetAttribute((const void*)mk_fwd, hipFuncAttributeMaxDynamicSharedMemorySize, LDS_BYTES) != hipSuccess) { fprintf(stderr, "kernel_launch: hipFuncSetAttribute failed\n"); return; }
        int dev = 0, cus = 0, per_cu = 0;
        if (hipGetDevice(&dev) != hipSuccess || hipDeviceGetAttribute(&cus, hipDeviceAttributeMultiprocessorCount, dev) != hipSuccess) { fprintf(stderr, "kernel_launch: device query failed\n"); return; }
        if (hipOccupancyMaxActiveBlocksPerMultiprocessor(&per_cu, (const void*)mk_fwd, NTHR, LDS_BYTES) != hipSuccess || per_cu < 1) { fprintf(stderr, "kernel_launch: occupancy query says %d blocks per CU\n", per_cu); (void)hipGetLastError(); }
        if (cus < NBLK) { fprintf(stderr, "kernel_launch: %d CUs < %d workgroups: the grid would not be resident\n", cus, NBLK); return; }
        ready = 1;
    }
    if (ready < 0) return;
    if (hipMemsetAsync((char*)d_ws + WS_CTL, 0, ZERO_BYTES, stream) != hipSuccess) { fprintf(stderr, "kernel_launch: memset failed\n"); return; }
    Params p{};
    const float** f = (const float**)&p;
    for (int i = 0; i < 23; ++i) f[i] = (const float*)d_in[i];
    p.out = (float*)d_out; p.ws = (unsigned char*)d_ws;
#if MK_MULTI
    for (int ph = 0; ph < NPHASES; ++ph) { p.ph_lo = ph; p.ph_hi = ph + 1; hipLaunchKernelGGL(mk_fwd, dim3(NBLK), dim3(NTHR), LDS_BYTES, stream, p); }
#else
    p.ph_lo = 0; p.ph_hi = NPHASES;
    hipLaunchKernelGGL(mk_fwd, dim3(NBLK), dim3(NTHR), LDS_BYTES, stream, p);
#endif
    const hipError_t le = hipPeekAtLastError();
    if (le != hipSuccess) fprintf(stderr, "kernel_launch: launch failed: %s\n", hipGetErrorName(le));
}
```

```cpp
#include <hip/hip_runtime.h>
#include <cstdio>
#include <cstdint>

#ifndef MK_MULTI
#define MK_MULTI 0
#endif

#define LAS __attribute__((address_space(3)))
#define GAS __attribute__((address_space(1)))
#define DI __device__ __forceinline__
typedef unsigned short bf16_t;
typedef short bf16x8 __attribute__((ext_vector_type(8)));
typedef short s16x4 __attribute__((ext_vector_type(4)));
typedef float f32x2 __attribute__((ext_vector_type(2)));
typedef float f32x4 __attribute__((ext_vector_type(4)));
typedef float f32x16 __attribute__((ext_vector_type(16)));
typedef unsigned u32x2 __attribute__((ext_vector_type(2)));
typedef unsigned u32x4 __attribute__((ext_vector_type(4)));

constexpr int DM = 2048, NB_P = 2, SEQ = 4096, DEPTH = 4, NB_S = 32, SSEQ = 64, PAST = 2048;
constexpr int MP = NB_P * SEQ, MS = NB_S * SSEQ, M = MP + MS;
constexpr int NEVEN = 2, NODD = 2, HR = 4, DKR = 256, HF = 8, DHF = 128, RW = 1024, FW = 1024, MIXW = 2048;
constexpr int INW = 7176, INW_P = 7168, DFF = 5632, PLE = 256, PBUF = 15;
#ifndef LDF_PAD
#define LDF_PAD 64
#endif
constexpr int LDF = DFF + LDF_PAD;
constexpr float EPS = 1e-6f;
constexpr int NBLK = 256, NTHR = 512;

constexpr size_t O_YP = 0, O_YS = O_YP + (size_t)MP * DM, O_RSP = O_YS + (size_t)MS * DM, O_RSS = O_RSP + (size_t)NEVEN * NB_P * HR * 65536,
                 O_KP = O_RSS + (size_t)NEVEN * NB_S * HR * 65536, O_KS = O_KP + (size_t)NEVEN * MP * FW, O_VP = O_KS + (size_t)NEVEN * MS * FW,
                 O_VS = O_VP + (size_t)NEVEN * MP * FW, O_LP = O_VS + (size_t)NEVEN * MS * FW, O_LS = O_LP + (size_t)NEVEN * MP * HF,
                 O_PP = O_LS + (size_t)NEVEN * MS * HF, O_PS = O_PP + (size_t)NODD * NB_P * PBUF * DM, O_END = O_PS + (size_t)NODD * NB_S * PBUF * DM;

constexpr size_t al256(size_t x) { return (x + 255) & ~(size_t)255; }
constexpr size_t WS_CTL = 0, CTL_BYTES = 1u << 20;
constexpr size_t WS_SS = WS_CTL + CTL_BYTES, SS_BYTES = 2u << 20;
constexpr size_t ZERO_BYTES = CTL_BYTES + SS_BYTES;
constexpr size_t WS_ROPE = WS_SS + SS_BYTES;
constexpr size_t WS_GWF = WS_ROPE + (size_t)4096 * 128 * 8;
constexpr size_t WS_WIN = al256(WS_GWF + (size_t)2 * 2048 * 8 * 4);
constexpr size_t WS_WOUT = WS_WIN + (size_t)2 * INW_P * DM * 2;
constexpr size_t WS_WGU = WS_WOUT + (size_t)2 * DM * MIXW * 2;
constexpr size_t WS_WDN = WS_WGU + (size_t)4 * 2 * DFF * DM * 2;
constexpr size_t WS_WPG = WS_WDN + (size_t)4 * DM * LDF * 2;
constexpr size_t WS_WPP = WS_WPG + (size_t)4 * DM * DM * 2;
constexpr size_t WS_WPL = WS_WPP + (size_t)4 * DM * PLE * 2;
constexpr size_t WS_PB = WS_WPL + (size_t)2 * DM * 512 * 2;
constexpr size_t WS_PPJ = WS_PB + (size_t)4 * M * PLE * 2;
constexpr size_t WS_XRES = WS_PPJ + (size_t)4 * M * DM * 2;
constexpr size_t WS_XB0 = WS_XRES + (size_t)M * DM * 4;
constexpr size_t WS_XB1 = WS_XB0 + (size_t)M * DM * 2;
constexpr size_t WS_MIXA = WS_XB1 + (size_t)M * DM * 2;
constexpr size_t WS_ACT = WS_MIXA + (size_t)M * DM * 2;
constexpr size_t WS_QR = WS_ACT + (size_t)M * LDF * 2;
constexpr size_t SZ_R = (size_t)M * RW * 2;
constexpr size_t WS_QD = WS_QR + SZ_R, WS_KR = WS_QD + SZ_R, WS_KD = WS_KR + SZ_R, WS_VR = WS_KD + SZ_R, WS_GR = WS_VR + SZ_R;
constexpr size_t WS_QF = WS_GR + SZ_R;
constexpr size_t SZ_F = (size_t)MP * FW * 2;
constexpr size_t WS_KF = WS_QF + SZ_F, WS_VF = WS_KF + SZ_F;
constexpr size_t WS_QS32 = WS_VF + SZ_F;
constexpr size_t WS_SPREV = WS_QS32 + (size_t)(MS + 256) * FW * 4;
constexpr size_t WS_XDUM = WS_SPREV + (size_t)8 * 64 * 65536 * 2;
constexpr size_t WS_XBDUM = WS_XDUM + (size_t)M * DM * 4;
constexpr size_t WS_SLAB = WS_XBDUM + (size_t)M * DM * 2;
constexpr size_t WS_END = WS_SLAB + (size_t)64 * 4 * 65536 * 4;

constexpr int CW_BAR = 4096;
constexpr int CW_DEP = 16384;
constexpr int CW_Q = 8192;

constexpr int LDS_MAIN = 131072;
constexpr int LDS_MISC = LDS_MAIN;
constexpr int LDS_BYTES = LDS_MAIN + 256;

#define VM_WAIT() asm volatile("s_waitcnt vmcnt(0)" ::: "memory")
#define LDS_WAIT() asm volatile("s_waitcnt lgkmcnt(0)" ::: "memory")
#define LDS_BARRIER() do { asm volatile("s_waitcnt lgkmcnt(0)" ::: "memory"); __builtin_amdgcn_s_barrier(); asm volatile("" ::: "memory"); } while (0)
DI unsigned cvt_pk_bf16(float lo, float hi) { unsigned r; asm volatile("v_cvt_pk_bf16_f32 %0, %1, %2" : "=v"(r) : "v"(lo), "v"(hi)); return r; }
DI int opaque_tid() { int t = threadIdx.x; asm volatile("" : "+v"(t)); return t; }
DI int launder_i(int v) { asm volatile("" : "+s"(v)); return v; }
typedef unsigned long long u64;
DI u64 ss_fix(float s) { return (u64)(s * 16777216.0f); }
DI float ss_val(u64 v) { return (float)v * (1.0f / 16777216.0f); }
DI bf16_t f2bf(float f) { unsigned u = __float_as_uint(f); u += 0x7fffu + ((u >> 16) & 1u); return (bf16_t)(u >> 16); }
DI float bf2f(unsigned short b) { return __uint_as_float(((unsigned)b) << 16); }
DI float shfl_xor_f(float v, int m) { const int l = (opaque_tid() & 63) ^ m; return __int_as_float(__builtin_amdgcn_ds_bpermute(l << 2, __float_as_int(v))); }
DI double shfl_up_d(double v, int o) { int l = (opaque_tid() & 63) - o; l = l < 0 ? l + o : l; const long long b = __double_as_longlong(v);
    const int lo = __builtin_amdgcn_ds_bpermute(l << 2, (int)(b & 0xffffffffll)), hi = __builtin_amdgcn_ds_bpermute(l << 2, (int)(b >> 32));
    return __longlong_as_double(((long long)hi << 32) | (unsigned)lo); }
DI float wave_sum(float v) {
#pragma unroll
    for (int o = 1; o < 64; o <<= 1) v += shfl_xor_f(v, o);
    return v;
}
DI int row_pos(int m) { return m < MP ? (m & (SEQ - 1)) : PAST + ((m - MP) & (SSEQ - 1)); }

#define XB_TMO      128
#define XB_XCNT(j)  (256  + 64 * (j))
#define XB_XSUB(j)  (1280 + 64 * (j))
#define XB_XGEN(j)  (2304 + 64 * (j))
#define XB_TOP      3328
#define XB_TOPGEN   3392
#define XCD_BAR_WORDS 3456
#define XB_SPIN_CAP (1u << 18)

__device__ __forceinline__ unsigned xb_ld(unsigned* p)              { return __hip_atomic_load(p, __ATOMIC_RELAXED, __HIP_MEMORY_SCOPE_AGENT); }
__device__ __forceinline__ unsigned xb_add(unsigned* p, unsigned v) { return __hip_atomic_fetch_add(p, v, __ATOMIC_RELAXED, __HIP_MEMORY_SCOPE_AGENT); }
__device__ __forceinline__ unsigned xb_xcc_id() { return (unsigned)__builtin_amdgcn_s_getreg((3 << 11) | 20) & 0xFu; }
#define XB_SPIN(cond, bar) do { unsigned _sp = 0; while (cond) { __builtin_amdgcn_s_sleep(1); \
    if ((++_sp & 255u) == 0u) { if (xb_ld(&(bar)[XB_TMO])) break; if (_sp > XB_SPIN_CAP) { atomicAdd(&(bar)[XB_TMO], 1u); break; } } } } while (0)

struct XcdBarrier {
    unsigned* bar; unsigned x;
    volatile LAS unsigned* st;
};

__device__ __forceinline__ XcdBarrier xcd_barrier_post(unsigned* bar, volatile LAS unsigned* st) {
    XcdBarrier b; b.bar = bar; b.x = xb_xcc_id(); b.st = st;
    if (threadIdx.x == 0) (void)xb_add(&bar[XB_XCNT(b.x)], 1u);
    return b;
}
__device__ __forceinline__ void xcd_barrier_complete(unsigned* bar, unsigned x, unsigned& nloc, unsigned& nx) {
    const unsigned G = gridDim.x * gridDim.y * gridDim.z;
    unsigned sum, cnt, mine, sp = 0u;
    for (;;) {
        sum = 0u; cnt = 0u; mine = 0u;
#pragma unroll
        for (unsigned j = 0; j < 16; ++j) { const unsigned c = xb_ld(&bar[XB_XCNT(j)]); sum += c; cnt += (c > 0u) ? 1u : 0u; mine = (j == x) ? c : mine; }
        if (sum == G) break;
        __builtin_amdgcn_s_sleep(1);
        if ((++sp & 255u) == 0u) { if (xb_ld(&bar[XB_TMO])) break; if (sp > XB_SPIN_CAP) { atomicAdd(&bar[XB_TMO], 1u); break; } }
    }
    nloc = mine > 0u ? mine : 1u; nx = cnt > 0u ? cnt : 1u;
}

__device__ __forceinline__ void xcd_barrier(const XcdBarrier& b) {
    asm volatile("s_waitcnt vmcnt(0)" ::: "memory");
    __syncthreads();
    if (threadIdx.x == 0) {
        unsigned* bar = b.bar;
        __builtin_amdgcn_s_waitcnt(0);
        unsigned nloc = b.st[0], nx = b.st[1];
        if (nloc == 0u) { xcd_barrier_complete(bar, b.x, nloc, nx); b.st[0] = nloc; b.st[1] = nx; }
        const unsigned old = xb_add(&bar[XB_XSUB(b.x)], 1u);
        const unsigned gen = old / nloc;
        if (old + 1u == (gen + 1u) * nloc) {
            __builtin_amdgcn_fence(__ATOMIC_RELEASE, "agent");
            asm volatile("s_waitcnt vmcnt(0)" ::: "memory");
            const unsigned og = xb_add(&bar[XB_TOP], 1u);
            const unsigned tg = og / nx;
            if (og + 1u == (tg + 1u) * nx) xb_add(&bar[XB_TOPGEN], 1u);
            else XB_SPIN(xb_ld(&bar[XB_TOPGEN]) == tg, bar);
            __builtin_amdgcn_fence(__ATOMIC_ACQUIRE, "agent");
            xb_add(&bar[XB_XGEN(b.x)], 1u);
            asm volatile("s_waitcnt vmcnt(0)" ::: "memory");
        } else {
            XB_SPIN(xb_ld(&bar[XB_XGEN(b.x)]) == gen, bar);
            __builtin_amdgcn_fence(__ATOMIC_ACQUIRE, "agent");
            asm volatile("s_waitcnt vmcnt(0)" ::: "memory");
        }
    }
    __syncthreads();
}
#ifndef STAGGER
#define STAGGER 1
#endif
#ifndef PG8_WGM
#define PG8_WGM 4
#endif
namespace pg8 {
#define PG8_LAS __attribute__((address_space(3)))
constexpr int BM = 256, BK = 64, HALF = 128, HTB = HALF * BK * 2  , STAGE_BYTES = 8 * HTB, NXCD = 8, WGM = PG8_WGM;

__host__ __device__ __forceinline__ int lds_byte(int r, int c) { const int st = (r >> 4) * 2 + (c >> 5), rr = r & 15, cc = c & 31, ob = rr * 64 + cc * 2; return st * 1024 + (ob ^ (((ob >> 9) & 1) << 5)); }
__host__ __device__ __forceinline__ void stage_rc(int b, int& R, int& C) { const int st = b / 1024, sb = b % 1024, swz = sb ^ (((sb >> 9) & 1) << 5); R = (st >> 1) * 16 + swz / 64; C = (st & 1) * 32 + (swz % 64) / 2; }
__host__ __device__ __forceinline__ int perm32(int rho) { const int n = rho >> 4, i = rho & 15; return 8 * (i >> 2) + 4 * n + (i & 3); }

template <int V> struct IC { static constexpr int v = V; };
struct Unit { int pm, pn, k0, nt, kq, li; };
struct Gemm { int lda, ldb, K; };

struct StaticOrder {
    int nM, nN, nwg, G, c;
    const bf16_t* A; const bf16_t* Bt; int lda, ldb;
    int a_kgrp;
    int a_kgrp_div;
    int b_mgrp;
    int b_mrows;
    int ntk;
    int rot;
    int split;
    int nomma;
    __device__ void init(int M_, int N_, int G_, int c_, const bf16_t* A_, const bf16_t* Bt_, int lda_, int ldb_, int K_) {
        nM = M_ / BM; nN = N_ / BM; nwg = nM * nN; G = G_; c = c_; A = A_; Bt = Bt_; lda = lda_; ldb = ldb_; a_kgrp = 0; a_kgrp_div = 1; b_mgrp = 0; b_mrows = 0; ntk = K_ / BK; split = 0; rot = 0; nomma = 0; }
    __device__ void tile_of(int L, Unit& u) const {
        int wgid = L; { const int q = nwg / NXCD, r = nwg % NXCD, xcd = wgid % NXCD; int off = wgid / NXCD;
            if (rot && r == 0) { off += xcd * rot; off -= (off >= q) ? q : 0; }
            wgid = (xcd < r ? xcd * (q + 1) : r * (q + 1) + (xcd - r) * q) + off; }
        const int nig = WGM * nN, gid = wgid / nig, fm = gid * WGM, gsz = (nM - fm) < WGM ? (nM - fm) : WGM;
        u.pm = fm + ((wgid % nig) % gsz); u.pn = (wgid % nig) / gsz;
    }
    __device__ int nfull() const { return split ? (nwg / G) * G : nwg; }
    __device__ bool next(int i, Unit& u) const {
        const int nf = nfull(), q4 = ntk / 4, ip = nwg / G;
        const int li = (split == 2) ? 8 * (c >> 5) + (c & 7) : c >> 2;
        const int kqv = (split == 2) ? (c >> 3) & 3 : c & 3;
        if (split == 1 && STAGGER && (c & 1)) i = (i == 0) ? ip : (i == ip) ? 0 : i;
        const long L = (long)i * G + c;
        const bool full = L < nf;
        const bool part = !full && split && i == nwg / G && li < nwg - nf;
        if (!full && !part) return false;
        Unit t; tile_of(full ? (int)L : nf + li, t);
        const bool wholeK = full || split == 2;
        t.kq = full ? -1 : kqv; t.nt = wholeK ? ntk : q4; t.k0 = wholeK ? 0 : kqv * q4 * BK; t.li = full ? 0 : li;
        u = t; return true;
    }
    __device__ __forceinline__ const char* aptr(const Unit& u) const { return (const char*)(A + (size_t)u.pm * BM * lda + (a_kgrp ? (size_t)(u.pn / a_kgrp_div) * a_kgrp : (size_t)0) + u.k0); }
    __device__ __forceinline__ const char* bptr(const Unit& u) const { return (const char*)(Bt + ((size_t)u.pn * BM + (b_mgrp ? (size_t)(u.pm / b_mgrp) * b_mrows : (size_t)0)) * ldb + u.k0); }
    __device__ __forceinline__ void a_ready(const Unit&) const {}
    __device__ __forceinline__ void done(const Unit&) const {}
};


#ifndef PG8_ALIGN
#define PG8_ALIGN true
#endif
template <class Epi, class Sched, bool ALIGN_EPI = PG8_ALIGN, bool QT = false>
__device__ __forceinline__ void gemm_phase(PG8_LAS unsigned char* lds, const Gemm g, const Sched& S, const Epi& E) {
    const int tid = opaque_tid(), wid = __builtin_amdgcn_readfirstlane(tid >> 6), lane = tid & 63, wr = wid >> 2, wc = wid & 3, fr = lane & 15, fq = lane >> 4;
    unsigned voffA[2], voffB[2];
#pragma unroll
    for (int i = 0; i < 2; ++i) { int R, C; stage_rc(tid * 16 + i * 8192, R, C);
        voffA[i] = (unsigned)(R * g.lda + C) * 2u; voffB[i] = (unsigned)(R * g.ldb + C) * 2u; }
    const size_t kstep = (size_t)(BK * 2);
    const size_t hstepA = (size_t)HALF * g.lda * 2, hstepB = (size_t)HALF * g.ldb * 2;
    const unsigned ldsw = (unsigned)wid * 1024u;
    const int aoff = lds_byte(wr * 64 + fr, fq * 8), boff = lds_byte(wc * 32 + fr, fq * 8);
#define PG8_SA(b, h) (((b) * 2 + (h)) * HTB)
#define PG8_SB(b, h) ((4 + (b) * 2 + (h)) * HTB)
#define PG8_STAGE(bufoff, gbase, voff) do { _Pragma("unroll") for (int _i = 0; _i < 2; ++_i) \
        __builtin_amdgcn_global_load_lds((const unsigned*)((const char*)(gbase) + (voff)[_i]), (PG8_LAS unsigned*)(lds + (bufoff) + ldsw + _i * 8192), 16, 0, 0); } while (0)
#define PG8_LDA1(dst, b, h, m, k) dst[m][k] = *(const PG8_LAS bf16x8*)(lds + PG8_SA(b, h) + aoff + (m) * 2048 + (k) * 1024)
#define PG8_LDA(dst, b, h) do { PG8_LDA1(dst, b, h, 0, 0); PG8_LDA1(dst, b, h, 0, 1); PG8_LDA1(dst, b, h, 1, 0); PG8_LDA1(dst, b, h, 1, 1); PG8_LDA1(dst, b, h, 2, 0); PG8_LDA1(dst, b, h, 2, 1); PG8_LDA1(dst, b, h, 3, 0); PG8_LDA1(dst, b, h, 3, 1); } while (0)
#define PG8_LDB1(dst, b, h, n, k) dst[n][k] = *(const PG8_LAS bf16x8*)(lds + PG8_SB(b, h) + boff + (n) * 2048 + (k) * 1024)
#define PG8_LDB(dst, b, h) do { PG8_LDB1(dst, b, h, 0, 0); PG8_LDB1(dst, b, h, 0, 1); PG8_LDB1(dst, b, h, 1, 0); PG8_LDB1(dst, b, h, 1, 1); } while (0)
#define PG8_MMA(ai, bj, At, Bt) do { __builtin_amdgcn_s_setprio(1); _Pragma("unroll") for (int m = 0; m < 4; ++m) _Pragma("unroll") for (int n = 0; n < 2; ++n) _Pragma("unroll") for (int k = 0; k < 2; ++k) \
        acc[ai][bj][m][n] = __builtin_amdgcn_mfma_f32_16x16x32_bf16(Bt[n][k], At[m][k], acc[ai][bj][m][n], 0, 0, 0); __builtin_amdgcn_s_setprio(0); } while (0)
#define PG8_WAIT_V(n) asm volatile("s_waitcnt vmcnt(" #n ")" ::: "memory")
#define PG8_WAIT_L(n) asm volatile("s_waitcnt lgkmcnt(" #n ")" ::: "memory")
#define PG8_BAR __builtin_amdgcn_s_barrier()
#define PG8_SCHED __builtin_amdgcn_sched_barrier(0)
    Unit cur, nxt; int ui = 0;
    if (!S.next(0, cur)) return;
    f32x4 acc[2][2][4][2];
#pragma unroll
    for (int a = 0; a < 2; ++a)
#pragma unroll
        for (int b = 0; b < 2; ++b)
#pragma unroll
            for (int m = 0; m < 4; ++m)
#pragma unroll
                for (int n = 0; n < 2; ++n) acc[a][b][m][n] = (f32x4){0.f, 0.f, 0.f, 0.f};
    bf16x8 At[4][2], B0[2][2], B1[2][2];
    const char* cA = S.aptr(cur); const char* cB = S.bptr(cur);
    S.a_ready(cur);
    PG8_STAGE(PG8_SB(0, 0), cB, voffB); PG8_STAGE(PG8_SB(0, 1), cB + hstepB, voffB); PG8_STAGE(PG8_SA(0, 0), cA, voffA); PG8_STAGE(PG8_SA(0, 1), cA + hstepA, voffA);
    if (wr == 1) PG8_BAR;
    PG8_WAIT_V(2); PG8_BAR;
    PG8_STAGE(PG8_SB(1, 0), cB + kstep, voffB); PG8_STAGE(PG8_SA(1, 0), cA + kstep, voffA); PG8_STAGE(PG8_SB(1, 1), cB + hstepB + kstep, voffB);
    PG8_WAIT_V(6); PG8_BAR;
    for (;;) {
        const bool has_next = S.next(ui + 1, nxt);
        const char* nA = has_next ? S.aptr(nxt) : cA; const char* nB = has_next ? S.bptr(nxt) : cB;
        const int nt = cur.nt;
        auto kloop = [&](auto mqc) {
            constexpr int MQ = decltype(mqc)::v;
#define PG8_DO(ai, bj) (MQ < 0 || MQ == (ai) * 2 + (bj))
#define PG8_DOA(ai) (MQ < 0 || (MQ < 4 && (MQ >> 1) == (ai)))
#define PG8_DOB(bj) (MQ < 0 || (MQ < 4 && (MQ & 1) == (bj)))
#define PG8_WAIT_Q do { if constexpr (MQ < 0) PG8_WAIT_V(8); else PG8_WAIT_V(4); } while (0)
        for (int t = 0; t < nt; t += 2) {
            const bool last = (t == nt - 2);
            const char* a1 = cA + (size_t)(t + 1) * kstep;
            const char* a2 = last ? nA : cA + (size_t)(t + 2) * kstep; const char* b2 = last ? nB : cB + (size_t)(t + 2) * kstep;
            const char* a3 = a2 + kstep; const char* b3 = b2 + kstep;
            if (last && has_next) S.a_ready(nxt);
            if constexpr (PG8_DOB(0)) PG8_LDB(B0, 0, 0); if constexpr (PG8_DOB(1)) PG8_LDB(B1, 0, 1); PG8_SCHED; if constexpr (PG8_DOA(0)) PG8_LDA(At, 0, 0); if constexpr (PG8_DOA(1)) PG8_STAGE(PG8_SA(1, 1), a1 + hstepA, voffA);
            PG8_WAIT_Q; PG8_WAIT_L(0); PG8_BAR; if constexpr (PG8_DO(0, 0)) PG8_MMA(0, 0, At, B0); if constexpr (PG8_DO(0, 1)) PG8_MMA(0, 1, At, B1); PG8_BAR; PG8_SCHED;
            if constexpr (PG8_DOA(1)) PG8_LDA(At, 0, 1); if constexpr (PG8_DOB(0)) PG8_STAGE(PG8_SB(0, 0), b2, voffB); if constexpr (PG8_DOB(1)) PG8_STAGE(PG8_SB(0, 1), b2 + hstepB, voffB); if constexpr (PG8_DOA(0)) PG8_STAGE(PG8_SA(0, 0), a2, voffA);
            PG8_WAIT_Q; PG8_WAIT_L(0); PG8_BAR; if constexpr (PG8_DO(1, 0)) PG8_MMA(1, 0, At, B0); if constexpr (PG8_DO(1, 1)) PG8_MMA(1, 1, At, B1); PG8_BAR; PG8_SCHED;
            if constexpr (PG8_DOB(0)) PG8_LDB(B0, 1, 0); if constexpr (PG8_DOB(1)) PG8_LDB(B1, 1, 1); PG8_SCHED; if constexpr (PG8_DOA(0)) PG8_LDA(At, 1, 0); if constexpr (PG8_DOA(1)) PG8_STAGE(PG8_SA(0, 1), a2 + hstepA, voffA);
            PG8_WAIT_Q; PG8_WAIT_L(0); PG8_BAR; if constexpr (PG8_DO(0, 0)) PG8_MMA(0, 0, At, B0); if constexpr (PG8_DO(0, 1)) PG8_MMA(0, 1, At, B1); PG8_BAR; PG8_SCHED;
            if constexpr (PG8_DOA(1)) PG8_LDA(At, 1, 1); if constexpr (PG8_DOB(0)) PG8_STAGE(PG8_SB(1, 0), b3, voffB); if constexpr (PG8_DOB(1)) PG8_STAGE(PG8_SB(1, 1), b3 + hstepB, voffB); if constexpr (PG8_DOA(0)) PG8_STAGE(PG8_SA(1, 0), a3, voffA);
            PG8_WAIT_Q; PG8_WAIT_L(0); PG8_BAR; if constexpr (PG8_DO(1, 0)) PG8_MMA(1, 0, At, B0); if constexpr (PG8_DO(1, 1)) PG8_MMA(1, 1, At, B1); PG8_BAR; PG8_SCHED;
        }
#undef PG8_DO
#undef PG8_DOA
#undef PG8_DOB
#undef PG8_WAIT_Q
        };
        if constexpr (QT) { const int mq = (S.split == 2) ? cur.kq : -1;
            if (mq < 0) kloop(IC<-1>{}); else if (mq == 0) kloop(IC<0>{}); else if (mq == 1) kloop(IC<1>{}); else if (mq == 2) kloop(IC<2>{}); else kloop(IC<3>{}); }
        else kloop(IC<-1>{});
        if constexpr (ALIGN_EPI) { if (wr == 0) PG8_BAR; }
        if (cur.kq < 0) E(acc, cur, wr, wc, fr, fq); else E.partial(acc, cur, wr, wc);
        if (!has_next) break;
#pragma unroll
        for (int a = 0; a < 2; ++a)
#pragma unroll
            for (int b = 0; b < 2; ++b)
#pragma unroll
                for (int m = 0; m < 4; ++m)
#pragma unroll
                    for (int n = 0; n < 2; ++n) acc[a][b][m][n] = (f32x4){0.f, 0.f, 0.f, 0.f};
        cur = nxt; cA = nA; cB = nB; ++ui;
        if constexpr (ALIGN_EPI) { if (wr == 1) PG8_BAR; }
    }
    PG8_WAIT_V(0);
    if constexpr (!ALIGN_EPI) { if (wr == 0) PG8_BAR; }
    PG8_BAR;
#undef PG8_SA
#undef PG8_SB
#undef PG8_STAGE
#undef PG8_LDA
#undef PG8_LDA1
#undef PG8_LDB1
#undef PG8_LDB
#undef PG8_MMA
#undef PG8_WAIT_V
#undef PG8_WAIT_L
#undef PG8_BAR
#undef PG8_SCHED
}
}
typedef f32x4 Acc[2][2][4][2];
DI float log2g_of(int h) { return h == 0 ? -0.04580368961312479f : h == 1 ? -0.02272007650008353f : h == 2 ? -0.011315313227834146f : -0.005646563141142063f; }
DI u32x4 pack8f(f32x4 a, f32x4 b) { u32x4 w; w.x = cvt_pk_bf16(a[0], a[1]); w.y = cvt_pk_bf16(a[2], a[3]); w.z = cvt_pk_bf16(b[0], b[1]); w.w = cvt_pk_bf16(b[2], b[3]); return w; }
DI float fsilu(float x) { return x * __builtin_amdgcn_rcpf(1.0f + __builtin_amdgcn_exp2f(-1.4426950408889634f * x)); }
DI float fsigm(float x) { return __builtin_amdgcn_rcpf(1.0f + __builtin_amdgcn_exp2f(-1.4426950408889634f * x)); }
DI f32x4 silu4(f32x4 v) { return (f32x4){fsilu(v[0]), fsilu(v[1]), fsilu(v[2]), fsilu(v[3])}; }
DI float rs_of(const u64* ss, int row) { return __builtin_amdgcn_rsqf(ss_val(ss[row]) * (1.0f / DM) + EPS); }

#ifndef WINR
#define WINR 3
#endif
struct EpiIn {
    static constexpr bool QT = false;
    unsigned char* ws; float* out; int e, slot;
    DI void partial(const Acc&, const pg8::Unit&, int, int) const {}
    DI void operator()(const Acc& acc, const pg8::Unit& u, int wr, int wc, int fr_, int fq_) const {
        (void)fr_; (void)fq_; const int lane_ = opaque_tid() & 63; const int fr = lane_ & 15, fq = lane_ >> 4;
        const int row0 = u.pm * 256 + wr * 64 + fr, cb = wc * 32 + 8 * fq, pn = u.pn;
        const bool prompt = u.pm < (MP / 256);
        const u64* ss = (const u64*)(ws + WS_SS) + (size_t)slot * M; const f32x2* rope = (const f32x2*)(ws + WS_ROPE);
        bf16_t *QR = (bf16_t*)(ws + WS_QR), *QD = (bf16_t*)(ws + WS_QD), *KR = (bf16_t*)(ws + WS_KR), *KD = (bf16_t*)(ws + WS_KD), *VR = (bf16_t*)(ws + WS_VR), *GR = (bf16_t*)(ws + WS_GR);
        bf16_t *QF = (bf16_t*)(ws + WS_QF), *KF = (bf16_t*)(ws + WS_KF), *VF = (bf16_t*)(ws + WS_VF); float* QS32 = (float*)(ws + WS_QS32);
        float* oKp = out + O_KP + (size_t)e * MP * FW; float* oKs = out + O_KS + (size_t)e * MS * FW; float* oVp = out + O_VP + (size_t)e * MP * FW; float* oVs = out + O_VS + (size_t)e * MS * FW;
        if (pn < 8) {
            const int head = pn & 3; const bool isK = pn >= 4; const float l2g = log2g_of(head);
            bf16_t* P0 = isK ? KR : QR; bf16_t* P1 = isK ? KD : QD;
            constexpr int W = WINR;
            f32x4 tb[W][4]; u64 sv[W];
#define EI_LOAD(q) do { const int row = row0 + ((q) >> 2) * 128 + ((q) & 3) * 16; sv[(q) % W] = ss[row]; const f32x4* tp = (const f32x4*)(rope + (size_t)row_pos(row) * 128 + cb); \
                tb[(q) % W][0] = tp[0]; tb[(q) % W][1] = tp[1]; tb[(q) % W][2] = tp[2]; tb[(q) % W][3] = tp[3]; } while (0)
#pragma unroll
            for (int q = 0; q < W; ++q) EI_LOAD(q);
#pragma unroll
            for (int q = 0; q < 8; ++q) {
                asm volatile("" ::: "memory");
                {
                    const int ai = q >> 2, m = q & 3;
                    const int row = row0 + ai * 128 + m * 16; const int pos = row_pos(row), ci = pos & 63;
                    const float rs = __builtin_amdgcn_rsqf(ss_val(sv[q % W]) * (1.0f / DM) + EPS) * (isK ? 0.0625f : 1.0f);
                    const float dec = __builtin_amdgcn_exp2f(l2g * (isK ? (float)(63 - ci) : (float)(ci + 1)));
                    const f32x4 t0 = tb[q % W][0], t1 = tb[q % W][1], t2 = tb[q % W][2], t3 = tb[q % W][3];
                    const f32x4 a0 = acc[ai][0][m][0] * rs, a1 = acc[ai][0][m][1] * rs, b0 = acc[ai][1][m][0] * rs, b1 = acc[ai][1][m][1] * rs;
                    f32x4 lo0, lo1, hi0, hi1;
                    lo0[0] = a0[0] * t0[0] - b0[0] * t0[1]; hi0[0] = a0[0] * t0[1] + b0[0] * t0[0];
                    lo0[1] = a0[1] * t0[2] - b0[1] * t0[3]; hi0[1] = a0[1] * t0[3] + b0[1] * t0[2];
                    lo0[2] = a0[2] * t1[0] - b0[2] * t1[1]; hi0[2] = a0[2] * t1[1] + b0[2] * t1[0];
                    lo0[3] = a0[3] * t1[2] - b0[3] * t1[3]; hi0[3] = a0[3] * t1[3] + b0[3] * t1[2];
                    lo1[0] = a1[0] * t2[0] - b1[0] * t2[1]; hi1[0] = a1[0] * t2[1] + b1[0] * t2[0];
                    lo1[1] = a1[1] * t2[2] - b1[1] * t2[3]; hi1[1] = a1[1] * t2[3] + b1[1] * t2[2];
                    lo1[2] = a1[2] * t3[0] - b1[2] * t3[1]; hi1[2] = a1[2] * t3[1] + b1[2] * t3[0];
                    lo1[3] = a1[3] * t3[2] - b1[3] * t3[3]; hi1[3] = a1[3] * t3[3] + b1[3] * t3[2];
                    const size_t o = (size_t)row * RW + head * 256 + cb;
                    *(u32x4*)(P0 + o) = pack8f(lo0, lo1); *(u32x4*)(P0 + o + 128) = pack8f(hi0, hi1);
                    *(u32x4*)(P1 + o) = pack8f(lo0 * dec, lo1 * dec); *(u32x4*)(P1 + o + 128) = pack8f(hi0 * dec, hi1 * dec);
                }
                asm volatile("" ::: "memory");
                if (q + W < 8) EI_LOAD(q + W);
            }
#undef EI_LOAD
        } else if (pn < 16) {
            const bool isG = pn >= 12; bf16_t* P = isG ? GR : VR; const int cbase = (pn & 3) * 256 + cb;
            u64 sv[8];
#pragma unroll
            for (int q = 0; q < 8; ++q) sv[q] = ss[row0 + (q >> 2) * 128 + (q & 3) * 16];
#pragma unroll
            for (int ai = 0; ai < 2; ++ai)
#pragma unroll
                for (int m = 0; m < 4; ++m) {
                    const int row = row0 + ai * 128 + m * 16; const float rs = __builtin_amdgcn_rsqf(ss_val(sv[ai * 4 + m]) * (1.0f / DM) + EPS);
#pragma unroll
                    for (int bj = 0; bj < 2; ++bj) { f32x4 v0 = acc[ai][bj][m][0] * rs, v1 = acc[ai][bj][m][1] * rs;
                        if (isG) { v0 = silu4(v0); v1 = silu4(v1); }
                        *(u32x4*)(P + (size_t)row * RW + cbase + bj * 128) = pack8f(v0, v1); }
                }
        } else {
            const int kind = (pn - 16) >> 2; const int cbase = (pn & 3) * 256 + cb;
            bf16_t* Pb = kind == 0 ? QF : kind == 1 ? KF : VF;
            float* Po = prompt ? (kind == 1 ? oKp : oVp) : (kind == 1 ? oKs : oVs);
            u64 sv[8];
#pragma unroll
            for (int q = 0; q < 8; ++q) sv[q] = ss[row0 + (q >> 2) * 128 + (q & 3) * 16];
#pragma unroll
            for (int ai = 0; ai < 2; ++ai)
#pragma unroll
                for (int m = 0; m < 4; ++m) {
                    const int row = row0 + ai * 128 + m * 16; const float rs = __builtin_amdgcn_rsqf(ss_val(sv[ai * 4 + m]) * (1.0f / DM) + EPS); const int lrow = prompt ? row : row - MP;
#pragma unroll
                    for (int bj = 0; bj < 2; ++bj) { const f32x4 v0 = acc[ai][bj][m][0] * rs, v1 = acc[ai][bj][m][1] * rs; const size_t o = (size_t)lrow * FW + cbase + bj * 128;
                        if (kind == 0) { if (prompt) *(u32x4*)(Pb + o) = pack8f(v0, v1); else { *(f32x4*)(QS32 + o) = v0; *(f32x4*)(QS32 + o + 4) = v1; } }
                        else { *(f32x4*)(Po + o) = v0; *(f32x4*)(Po + o + 4) = v1; if (prompt) *(u32x4*)(Pb + o) = pack8f(v0, v1); } }
                }
        }
    }
};

#ifndef WIN0
#define WIN0 8
#endif
#ifndef WIN1
#define WIN1 4
#endif
DI void unpack8(u32x4 q, f32x4& lo, f32x4& hi) {
    lo = (f32x4){__uint_as_float(q.x << 16), __uint_as_float(q.x & 0xffff0000u), __uint_as_float(q.y << 16), __uint_as_float(q.y & 0xffff0000u)};
    hi = (f32x4){__uint_as_float(q.z << 16), __uint_as_float(q.z & 0xffff0000u), __uint_as_float(q.w << 16), __uint_as_float(q.w & 0xffff0000u)};
}
template <int MODE> struct EpiRes {
    static constexpr bool QT = true;
    const bf16_t* xold; bf16_t* xb; u64* ssq_out; const u64* ss_in; const bf16_t* pp; float* slab;
    template <int AI, int BJ> DI void quarter(const Acc& acc, const pg8::Unit& u, int wr, int wc) const {
        const int lane_ = opaque_tid() & 63; const int fr = lane_ & 15, fq = lane_ >> 4;
        const int row0 = u.pm * 256 + AI * 128 + wr * 64 + fr, col = u.pn * 256 + BJ * 128 + wc * 32 + 8 * fq;
        u32x4 xo[4], pw[4]; u64 rsv[4];
#pragma unroll
        for (int m = 0; m < 4; ++m) { const int row = row0 + m * 16; xo[m] = *(const u32x4*)(xold + (size_t)row * DM + col);
            if (MODE == 1) { rsv[m] = ss_in[row]; pw[m] = *(const u32x4*)(pp + (size_t)row * DM + col); } }
#pragma unroll
        for (int m = 0; m < 4; ++m) { const int row = row0 + m * 16;
            f32x4 o0, o1; unpack8(xo[m], o0, o1);
            f32x4 v0 = acc[AI][BJ][m][0], v1 = acc[AI][BJ][m][1];
            if (MODE == 1) { const float rs = __builtin_amdgcn_rsqf(ss_val(rsv[m]) * (1.0f / DM) + EPS); f32x4 p0, p1; unpack8(pw[m], p0, p1);
#pragma unroll
                for (int j = 0; j < 4; ++j) { v0[j] = fsigm(v0[j] * rs) * p0[j]; v1[j] = fsigm(v1[j] * rs) * p1[j]; } }
            o0 += v0; o1 += v1;
            *(u32x4*)(xb + (size_t)row * DM + col) = pack8f(o0, o1);
            float s = (o0[0] * o0[0] + o0[1] * o0[1]) + (o0[2] * o0[2] + o0[3] * o0[3]) + (o1[0] * o1[0] + o1[1] * o1[1]) + (o1[2] * o1[2] + o1[3] * o1[3]);
            s += shfl_xor_f(s, 16); s += shfl_xor_f(s, 32);
            if (fq == 0) __hip_atomic_fetch_add(ssq_out + row, ss_fix(s), __ATOMIC_RELAXED, __HIP_MEMORY_SCOPE_AGENT); }
    }
    DI void partial(const Acc& acc, const pg8::Unit& u, int wr, int wc) const {
        if (slab == nullptr) { if (u.kq == 0) quarter<0, 0>(acc, u, wr, wc); else if (u.kq == 1) quarter<0, 1>(acc, u, wr, wc); else if (u.kq == 2) quarter<1, 0>(acc, u, wr, wc); else quarter<1, 1>(acc, u, wr, wc); return; }
        const int lane_ = opaque_tid() & 63; const int fr = lane_ & 15, fq = lane_ >> 4;
        float* d = slab + (size_t)(u.li * 4 + u.kq) * 65536 + (size_t)(wr * 64 + fr) * 256 + wc * 32 + 8 * fq;
#pragma unroll
        for (int ai = 0; ai < 2; ++ai)
#pragma unroll
            for (int bj = 0; bj < 2; ++bj)
#pragma unroll
                for (int m = 0; m < 4; ++m) { float* p = d + (size_t)(ai * 128 + m * 16) * 256 + bj * 128; *(f32x4*)p = acc[ai][bj][m][0]; *(f32x4*)(p + 4) = acc[ai][bj][m][1]; }
    }
    DI void operator()(const Acc& acc, const pg8::Unit& u, int wr, int wc, int fr_, int fq_) const {
        (void)fr_; (void)fq_; const int lane_ = opaque_tid() & 63; const int fr = lane_ & 15, fq = lane_ >> 4;
        const int row0 = u.pm * 256 + wr * 64 + fr, col0 = u.pn * 256 + wc * 32 + 8 * fq;
        constexpr int W = (MODE == 1) ? WIN1 : WIN0;
        u32x4 xo[W][2]; u32x4 pw[W][2]; u64 rsv[W];
#define ER_LOAD(q) do { const int row = row0 + ((q) >> 2) * 128 + ((q) & 3) * 16; \
            if (MODE == 1) rsv[(q) % W] = ss_in[row]; \
            _Pragma("unroll") for (int bj = 0; bj < 2; ++bj) { xo[(q) % W][bj] = *(const u32x4*)(xold + (size_t)row * DM + col0 + bj * 128); \
                if (MODE == 1) pw[(q) % W][bj] = *(const u32x4*)(pp + (size_t)row * DM + col0 + bj * 128); } } while (0)
#pragma unroll
        for (int q = 0; q < W; ++q) ER_LOAD(q);
#pragma unroll
        for (int q = 0; q < 8; ++q) {
            asm volatile("" ::: "memory");
            {
                const int ai = q >> 2, m = q & 3, row = row0 + ai * 128 + m * 16;
                float rs = 1.f; if (MODE == 1) rs = __builtin_amdgcn_rsqf(ss_val(rsv[q % W]) * (1.0f / DM) + EPS);
                float s = 0.f;
#pragma unroll
                for (int bj = 0; bj < 2; ++bj) { const int col = col0 + bj * 128;
                    f32x4 o0, o1; unpack8(xo[q % W][bj], o0, o1);
                    f32x4 v0 = acc[ai][bj][m][0], v1 = acc[ai][bj][m][1];
                    if (MODE == 1) { f32x4 p0, p1; unpack8(pw[q % W][bj], p0, p1);
#pragma unroll
                        for (int j = 0; j < 4; ++j) { v0[j] = fsigm(v0[j] * rs) * p0[j]; v1[j] = fsigm(v1[j] * rs) * p1[j]; } }
                    o0 += v0; o1 += v1;
                    *(u32x4*)(xb + (size_t)row * DM + col) = pack8f(o0, o1);
                    s += (o0[0] * o0[0] + o0[1] * o0[1]) + (o0[2] * o0[2] + o0[3] * o0[3]) + (o1[0] * o1[0] + o1[1] * o1[1]) + (o1[2] * o1[2] + o1[3] * o1[3]); }
                s += shfl_xor_f(s, 16); s += shfl_xor_f(s, 32);
                if (fq == 0) __hip_atomic_fetch_add(ssq_out + row, ss_fix(s), __ATOMIC_RELAXED, __HIP_MEMORY_SCOPE_AGENT);
            }
            asm volatile("" ::: "memory");
            if (q + W < 8) ER_LOAD(q + W);
        }
#undef ER_LOAD
    }
};

struct EpiAct {
    static constexpr bool QT = false;
    const u64* ss; bf16_t* act;
    DI void partial(const Acc&, const pg8::Unit&, int, int) const {}
    DI void operator()(const Acc& acc, const pg8::Unit& u, int wr, int wc, int fr_, int fq_) const {
        (void)fr_; (void)fq_; const int lane_ = opaque_tid() & 63; const int fr = lane_ & 15, fq = lane_ >> 4;
        const int row0 = u.pm * 256 + wr * 64 + fr, col0 = u.pn * 128 + wc * 32 + 8 * fq;
#pragma unroll
        for (int ai = 0; ai < 2; ++ai)
#pragma unroll
            for (int m = 0; m < 4; ++m) {
                const int row = row0 + ai * 128 + m * 16; const float rs = rs_of(ss, row);
                const f32x4 g0 = acc[ai][0][m][0] * rs, g1 = acc[ai][0][m][1] * rs, u0 = acc[ai][1][m][0] * rs, u1 = acc[ai][1][m][1] * rs;
                *(u32x4*)(act + (size_t)row * LDF + col0) = pack8f(silu4(g0) * u0, silu4(g1) * u1);
            }
    }
};

struct EpiBf {
    static constexpr bool QT = false;
    bf16_t* O; int ldc;
    DI void partial(const Acc&, const pg8::Unit&, int, int) const {}
    DI void operator()(const Acc& acc, const pg8::Unit& u, int wr, int wc, int fr_, int fq_) const {
        (void)fr_; (void)fq_; const int lane_ = opaque_tid() & 63; const int fr = lane_ & 15, fq = lane_ >> 4;
        const int row0 = u.pm * 256 + wr * 64 + fr, col0 = u.pn * 256 + wc * 32 + 8 * fq;
#pragma unroll
        for (int ai = 0; ai < 2; ++ai)
#pragma unroll
            for (int m = 0; m < 4; ++m) {
                const int row = row0 + ai * 128 + m * 16;
#pragma unroll
                for (int bj = 0; bj < 2; ++bj) *(u32x4*)(O + (size_t)row * ldc + col0 + bj * 128) = pack8f(acc[ai][bj][m][0], acc[ai][bj][m][1]);
            }
    }
};

struct EpiNull {
    static constexpr bool QT = false;
    float* sink;
    DI void partial(const Acc& acc, const pg8::Unit&, int, int) const { if (acc[0][0][0][0][0] == 12345.678f) sink[opaque_tid()] = acc[1][1][3][1][3]; }
    DI void operator()(const Acc& acc, const pg8::Unit&, int, int, int, int) const { float s = 0.f;
#pragma unroll
        for (int a = 0; a < 2; ++a)
#pragma unroll
            for (int b = 0; b < 2; ++b)
#pragma unroll
                for (int m = 0; m < 4; ++m)
#pragma unroll
                    for (int n = 0; n < 2; ++n) s += (acc[a][b][m][n][0] + acc[a][b][m][n][1]) + (acc[a][b][m][n][2] + acc[a][b][m][n][3]);
        if (s == 12345.678f) sink[opaque_tid()] = s; }
};
struct Params {
    const float *x_p, *x_s, *p_p, *p_s, *state_ret, *cache_k, *cache_v, *cache_lf, *state_pool;
    const float *norm_mix, *w_in, *b_forget, *w_out, *w_pool, *pool_scale, *norm_ffn, *w_gate, *w_up, *w_down, *norm_ple, *ple_gate, *ple_proj, *final_norm;
    float* out; unsigned char* ws;
    int ph_lo, ph_hi;
};
static_assert(sizeof(Params) % 8 == 0, "no tail padding");
typedef const __attribute__((address_space(4))) Params CP;
DI CP* launder_cp(CP* p) { asm volatile("" : "+s"(p)); return p; }

struct WJob { const float* src; const float* src2; const float* gain; const float* cscale; bf16_t* dst; int K, ld, coloff, nphys, type, ldd; };
constexpr int NJOBS = 22;
DI int job_items(int j) {
    return j < 2 ? 16 * 112 : j < 4 ? 16 * 32 : j < 8 ? 16 * 176 : j < 12 ? 44 * 32 : j < 16 ? 16 * 32 : j < 20 ? 2 * 32 : 4 * 32;
}
DI WJob get_job(CP& P, int j) {
    WJob w; w.src2 = nullptr; w.gain = nullptr; w.cscale = nullptr; w.coloff = 0; w.type = 0; w.ldd = 0;
    unsigned char* ws = P.ws;
    if (j < 2) { const int e = j; w.src = P.w_in + (size_t)e * DM * INW; w.ld = INW; w.K = DM; w.nphys = INW_P; w.gain = P.norm_mix + (size_t)(2 * e) * DM; w.dst = (bf16_t*)(ws + WS_WIN) + (size_t)e * INW_P * DM; }
    else if (j < 4) { const int e = j - 2; w.src = P.w_out + (size_t)e * MIXW * DM; w.ld = DM; w.K = MIXW; w.nphys = DM; w.dst = (bf16_t*)(ws + WS_WOUT) + (size_t)e * DM * MIXW; }
    else if (j < 8) { const int i = j - 4; w.src = P.w_gate + (size_t)i * DM * DFF; w.src2 = P.w_up + (size_t)i * DM * DFF; w.ld = DFF; w.K = DM; w.nphys = 2 * DFF; w.type = 1;
        w.gain = P.norm_ffn + (size_t)i * DM; w.dst = (bf16_t*)(ws + WS_WGU) + (size_t)i * 2 * DFF * DM; }
    else if (j < 12) { const int i = j - 8; w.src = P.w_down + (size_t)i * DFF * DM; w.ld = DM; w.K = DFF; w.nphys = DM; w.dst = (bf16_t*)(ws + WS_WDN) + (size_t)i * DM * LDF; w.ldd = LDF; }
    else if (j < 16) { const int i = j - 12; w.src = P.ple_gate + (size_t)i * DM * DM; w.ld = DM; w.K = DM; w.nphys = DM; w.gain = P.norm_ple + (size_t)i * DM; w.dst = (bf16_t*)(ws + WS_WPG) + (size_t)i * DM * DM; }
    else if (j < 20) { const int i = j - 16; w.src = P.ple_proj + (size_t)i * PLE * DM; w.ld = DM; w.K = PLE; w.nphys = DM; w.dst = (bf16_t*)(ws + WS_WPP) + (size_t)i * DM * PLE; }
    else { const int o = j - 20; w.src = P.w_pool + (size_t)o * 4 * 512 * 512; w.ld = 512; w.K = 512; w.nphys = DM; w.type = 2; w.cscale = P.pool_scale + (size_t)o * DM; w.dst = (bf16_t*)(ws + WS_WPL) + (size_t)o * DM * 512; }
    if (w.ldd == 0) w.ldd = w.K;
    return w;
}
struct WItem { const float* src; const float* gain; const float* cs; bf16_t* dst; int ld, ldd; };
DI int seq_job(int pos) { return pos < 12 ? (int)((330613888146214976ull >> (5 * pos)) & 31) : (int)((540123756432429ull >> (5 * (pos - 12))) & 31); }
#ifndef FILL_ON
#define FILL_ON 0
#endif
constexpr int NPRO = FILL_ON ? 7424 : 24064, NREST = FILL_ON ? 16640 : 0, QL1 = 4736, QL2 = 7040, QL3 = 11776;
DI WItem get_item(CP& P, int it) {
    int pos = 0;
    for (; pos < NJOBS - 1; ++pos) { const int n = job_items(seq_job(pos)); if (it < n) break; it -= n; }
    const WJob w = get_job(P, seq_job(pos));
    const int npt = w.nphys / 128, kt = it / npt, pt = it - kt * npt, k0 = kt * 64, p0 = pt * 128;
    WItem r; r.ld = w.ld; r.ldd = w.ldd; r.gain = w.gain ? w.gain + k0 : nullptr; r.cs = w.cscale ? w.cscale + p0 : nullptr; r.dst = w.dst + (size_t)p0 * w.ldd + k0;
    const float* s = w.src; int c0 = w.coloff + p0;
    if (w.type == 1) { const int t256 = p0 >> 8, within = p0 & 255; if (within >= 128) s = w.src2; c0 = t256 * 128 + (within & 127); }
    else if (w.type == 2) { s = w.src + (size_t)(p0 >> 9) * 512 * 512; c0 = p0 & 511; }
    r.src = s + (size_t)k0 * w.ld + c0;
    return r;
}
constexpr int NWITEMS = 2 * 16 * 112 + 2 * 16 * 32 + 4 * 16 * 176 + 4 * 44 * 32 + 4 * 16 * 32 + 4 * 2 * 32 + 2 * 4 * 32;

DI void sincos_d(double a, float& c, float& s) {
    const double q = __builtin_rint(a * 0.63661977236758134308);
    double y = __builtin_fma(-q, 1.57079632679489655800e+00, a); y = __builtin_fma(-q, 6.12323399573676603587e-17, y);
    const double y2 = y * y;
    double sp = 1.0 / 6227020800.0; sp = sp * y2 - 1.0 / 39916800.0; sp = sp * y2 + 1.0 / 362880.0; sp = sp * y2 - 1.0 / 5040.0; sp = sp * y2 + 1.0 / 120.0; sp = sp * y2 - 1.0 / 6.0; sp = sp * y2 * y + y;
    double cp = 1.0 / 479001600.0; cp = cp * y2 - 1.0 / 3628800.0; cp = cp * y2 + 1.0 / 40320.0; cp = cp * y2 - 1.0 / 720.0; cp = cp * y2 + 1.0 / 24.0; cp = cp * y2 - 0.5; cp = cp * y2 + 1.0;
    const int qi = (int)((long long)q & 3);
    const double ss = (qi == 0) ? sp : (qi == 1) ? cp : (qi == 2) ? -sp : -cp;
    const double cc = (qi == 0) ? cp : (qi == 1) ? -sp : (qi == 2) ? -cp : sp;
    c = (float)cc; s = (float)ss;
}

constexpr int CV_TS = 272;
DI int invperm32(int L) { return 16 * ((L >> 2) & 1) + 4 * (L >> 3) + (L & 3); }
DI void cv_store_tile(LAS unsigned char* T, const WItem& w, const f32x4 (&v)[4], int kk, int seg) {
    f32x4 cs4 = {1.f, 1.f, 1.f, 1.f}; if (w.cs) cs4 = *(const f32x4*)(w.cs + 4 * seg);
#pragma unroll
    for (int i = 0; i < 4; ++i) { const int k = kk + 16 * i; const float g = w.gain ? w.gain[k] : 1.0f; const f32x4 x = v[i] * g * cs4;
        u32x2 pk; pk.x = cvt_pk_bf16(x[0], x[1]); pk.y = cvt_pk_bf16(x[2], x[3]); *(LAS u32x2*)(T + k * CV_TS + seg * 8) = pk; }
}
DI void cv_emit(LAS unsigned char* T, const WItem& w, int wave, int lane) {
    const int s = 4 * wave + (lane >> 4), nb = s & 7, k0 = 16 * (s >> 3);
    const int i = lane & 15, q = i >> 2, p = i & 3, n = 16 * nb + i;
    const int ip = (n & ~31) + invperm32(n & 31);
    const unsigned a0 = (unsigned)(size_t)T + (unsigned)((k0 + q) * CV_TS + (16 * nb + 4 * p) * 2);
    s16x4 r0, r1, r2, r3;
    asm volatile("ds_read_b64_tr_b16 %0, %4\n\tds_read_b64_tr_b16 %1, %4 offset:1088\n\tds_read_b64_tr_b16 %2, %4 offset:2176\n\tds_read_b64_tr_b16 %3, %4 offset:3264\n\ts_waitcnt lgkmcnt(0)"
                 : "=&v"(r0), "=&v"(r1), "=&v"(r2), "=&v"(r3) : "v"(a0) : "memory");
    __builtin_amdgcn_sched_barrier(0);
    bf16_t* d = w.dst + (size_t)ip * w.ldd + k0;
    *(bf16x8*)d = __builtin_shufflevector(r0, r1, 0, 1, 2, 3, 4, 5, 6, 7);
    *(bf16x8*)(d + 8) = __builtin_shufflevector(r2, r3, 0, 1, 2, 3, 4, 5, 6, 7);
}

DI void convert_fill(CP& P, LAS unsigned char* lds, unsigned* head, volatile LAS unsigned* slot, int limit, int budget) {
    const int tid = opaque_tid();
    const int kk = tid >> 5, seg = tid & 31, lane = tid & 63, wave = tid >> 6;
    (void)budget;
#define CF_TAKE(dst) do { if (tid == 0) { const unsigned h_ = __hip_atomic_load(head, __ATOMIC_RELAXED, __HIP_MEMORY_SCOPE_AGENT); unsigned r_ = 0xffffffffu; \
        if (h_ < (unsigned)limit) { r_ = __hip_atomic_fetch_add(head, 4u, __ATOMIC_RELAXED, __HIP_MEMORY_SCOPE_AGENT); if (r_ >= (unsigned)NREST) r_ = 0xffffffffu; } *slot = r_; } \
        LDS_BARRIER(); dst = *slot; LDS_BARRIER(); } while (0)
#define CF_LOAD4(V, base) do { _Pragma("unroll") for (int b_ = 0; b_ < 4; ++b_) { const WItem w_ = get_item(P, NPRO + (int)(base) + b_); \
        _Pragma("unroll") for (int i = 0; i < 4; ++i) V[b_ * 4 + i] = *(const f32x4*)(w_.src + (size_t)(kk + 16 * i) * w_.ld + 4 * seg); } } while (0)
#define CF_PROC4(V, base) do { _Pragma("unroll") for (int b_ = 0; b_ < 4; ++b_) { const WItem w_ = get_item(P, NPRO + (int)(base) + b_); \
        const f32x4 (&vv_)[4] = *(const f32x4 (*)[4])&V[b_ * 4]; \
        cv_store_tile((LAS unsigned char*)lds, w_, vv_, kk, seg); \
        LDS_BARRIER(); \
        cv_emit((LAS unsigned char*)lds, w_, wave, lane); \
        LDS_BARRIER(); } } while (0)
    f32x4 va[16], vb[16];
    unsigned ia, ib;
    CF_TAKE(ia);
    if (ia == 0xffffffffu) return;
    CF_LOAD4(va, ia);
    for (;;) {
        CF_TAKE(ib);
        if (ib != 0xffffffffu) CF_LOAD4(vb, ib);
        CF_PROC4(va, ia);
        if (ib == 0xffffffffu) break;
        CF_TAKE(ia);
        if (ia != 0xffffffffu) CF_LOAD4(va, ia);
        CF_PROC4(vb, ib);
        if (ia == 0xffffffffu) break;
    }
#undef CF_TAKE
#undef CF_LOAD4
#undef CF_PROC4
}

DI void prologue(CP& P, LAS unsigned char* lds) {
    const int tid = opaque_tid(), lane = tid & 63, wave = tid >> 6, blk = blockIdx.x;
    unsigned char* ws = P.ws;
    {
        const int kk = tid >> 5, seg = tid & 31;
        f32x4 v[4];
        int it = blk;
        WItem cur = get_item(P, it < NPRO ? it : 0);
        if (it < NPRO) {
#pragma unroll
            for (int i = 0; i < 4; ++i) v[i] = *(const f32x4*)(cur.src + (size_t)(kk + 16 * i) * cur.ld + 4 * seg);
        }
        while (it < NPRO) {
            cv_store_tile(lds, cur, v, kk, seg);
            const int itn = it + NBLK;
            WItem nxt = cur;
            if (itn < NPRO) { nxt = get_item(P, itn);
#pragma unroll
                for (int i = 0; i < 4; ++i) v[i] = *(const f32x4*)(nxt.src + (size_t)(kk + 16 * i) * nxt.ld + 4 * seg); }
            LDS_BARRIER();
            cv_emit(lds, cur, wave, lane);
            LDS_BARRIER();
            cur = nxt; it = itn;
        }
    }
    const int gt = blk * NTHR + tid, NT = NBLK * NTHR;
    {
        bf16_t* PB = (bf16_t*)(ws + WS_PB);
        for (int i = gt; i < 4 * M * PLE / 8; i += NT) {
            const int e8 = i * 8, l = e8 / (M * PLE), rem = e8 - l * (M * PLE), m = rem / PLE, c = rem - m * PLE;
            const float* s = m < MP ? P.p_p + ((size_t)l * MP + m) * PLE + c : P.p_s + ((size_t)l * MS + (m - MP)) * PLE + c;
            *(u32x4*)(PB + (size_t)e8) = pack8f(*(const f32x4*)s, *(const f32x4*)(s + 4));
        }
    }
    {
        f32x2* R = (f32x2*)(ws + WS_ROPE);
        for (int i = gt; i < 4096 * 128; i += NT) { const int pos = i >> 7, j = i & 127;
            const double inv = exp2(-(double)j * (13.287712379549449 / 128.0));
            float c, s; sincos_d((double)pos * inv, c, s); R[i] = (f32x2){c, s}; }
    }
    {
        float* G = (float*)(ws + WS_GWF);
        for (int i = gt; i < 2 * DM * 8; i += NT) { const int e = i / (DM * 8), r = i - e * DM * 8, j = r / DM, k = r - j * DM;
            G[i] = P.norm_mix[(size_t)(2 * e) * DM + k] * P.w_in[((size_t)e * DM + k) * INW + INW_P + j]; }
    }
    {
        bf16_t* XB = (bf16_t*)(ws + WS_XB0); u64* SS = (u64*)(ws + WS_SS);
        for (int m = blk * 8 + wave; m < M; m += NBLK * 8) {
            const float* xr = m < MP ? P.x_p + (size_t)m * DM : P.x_s + (size_t)(m - MP) * DM;
            float s = 0.f;
#pragma unroll
            for (int j = 0; j < 4; ++j) { const f32x4 a = *(const f32x4*)(xr + j * 512 + lane * 8), b = *(const f32x4*)(xr + j * 512 + lane * 8 + 4);
                s += (a[0] * a[0] + a[1] * a[1]) + (a[2] * a[2] + a[3] * a[3]) + (b[0] * b[0] + b[1] * b[1]) + (b[2] * b[2] + b[3] * b[3]);
                *(u32x4*)(XB + (size_t)m * DM + j * 512 + lane * 8) = pack8f(a, b); }
            s = wave_sum(s);
            if (lane == 0) SS[m] = ss_fix(s);
        }
    }
}

template <class TX>
DI void fgate_units(CP& P, LAS unsigned char* lds, int e, const TX* xin_p, const TX* xin_s, const u64* ss) {
    const int tid = opaque_tid(), lane = tid & 63, wave = tid >> 6, blk = blockIdx.x;
    LAS float* G = (LAS float*)lds;
    const float* gsrc = (const float*)(P.ws + WS_GWF) + (size_t)e * DM * 8;
    for (int i = tid; i < DM * 8 / 4; i += NTHR) *(LAS f32x4*)(G + i * 4) = *(const f32x4*)(gsrc + i * 4);
    __syncthreads();
    for (int m = (blk - 96) * 8 + wave; blk >= 96 && m < M; m += 160 * 8) {
        const TX* xr = m < MP ? xin_p + (size_t)m * DM : xin_s + (size_t)(m - MP) * DM;
        asm volatile("" ::: "memory");
        float a[8] = {0.f, 0.f, 0.f, 0.f, 0.f, 0.f, 0.f, 0.f};
#pragma unroll
        for (int j = 0; j < 8; ++j) { const int k0 = j * 256 + lane * 4; f32x4 xv;
            if constexpr (sizeof(TX) == 4) xv = *(const f32x4*)(xr + k0);
            else { const u32x2 q_ = *(const u32x2*)(xr + k0); xv = (f32x4){__uint_as_float(q_.x << 16), __uint_as_float(q_.x & 0xffff0000u), __uint_as_float(q_.y << 16), __uint_as_float(q_.y & 0xffff0000u)}; }
#pragma unroll
            for (int t = 0; t < 8; ++t) { const f32x4 g = *(LAS f32x4*)(G + t * DM + k0);
                a[t] += (xv[0] * g[0] + xv[1] * g[1]) + (xv[2] * g[2] + xv[3] * g[3]); } }
#pragma unroll
        for (int j = 0; j < 8; ++j) a[j] = wave_sum(a[j]);
        if (lane < 8) {
            float v = a[0];
#pragma unroll
            for (int j = 1; j < 8; ++j) v = (lane == j) ? a[j] : v;
            const float z = v * rs_of(ss, m) + P.b_forget[e * 8 + lane];
            float ln2 = 0.6931471805599453f; asm volatile("" : "+v"(ln2));
            const float lf = fminf(z, 0.f) - ln2 * __builtin_amdgcn_logf(1.0f + __builtin_amdgcn_exp2f(-1.4426950408889634f * fabsf(z)));
            float* o = m < MP ? P.out + O_LP + ((size_t)e * MP + m) * 8 : P.out + O_LS + ((size_t)e * MS + (m - MP)) * 8;
            o[lane] = lf;
        }
    }
    __syncthreads();
}
namespace rt {
#define MFMA32(a, b, c) __builtin_amdgcn_mfma_f32_32x32x16_bf16((a), (b), (c), 0, 0, 0)
DI unsigned off_b(unsigned row, unsigned ch) { return 256u * row + 16u * (ch ^ (((row & 3) << 2) | ((row >> 2) & 3))); }
DI int crow(int reg, int h) { return (reg & 3) + 8 * (reg >> 2) + 4 * h; }
DI bf16x8 pack_step(const f32x16& x, int s) {
    u32x4 p;
    p.x = cvt_pk_bf16(x[8 * s + 0], x[8 * s + 1]); p.y = cvt_pk_bf16(x[8 * s + 2], x[8 * s + 3]); p.z = cvt_pk_bf16(x[8 * s + 4], x[8 * s + 5]); p.w = cvt_pk_bf16(x[8 * s + 6], x[8 * s + 7]);
    return __builtin_bit_cast(bf16x8, p);
}
DI unsigned tr_addr(unsigned img, unsigned row0, unsigned c, unsigned lane) {
    const unsigned blk = (lane >> 4) & 1, q = (lane & 15) >> 2, p = lane & 3;
    return img + off_b(row0 + q, 4 * c + 2 * blk + (p >> 1)) + 8 * (p & 1);
}
DI bf16x8 cat8(s16x4 lo, s16x4 hi) { return __builtin_shufflevector(lo, hi, 0, 1, 2, 3, 4, 5, 6, 7); }
DI void tr_read8(const unsigned (&a)[8], bf16x8 (&f)[4]) {
    s16x4 r0, r1, r2, r3, r4, r5, r6, r7;
    asm volatile("ds_read_b64_tr_b16 %0, %8\n\tds_read_b64_tr_b16 %1, %9\n\tds_read_b64_tr_b16 %2, %10\n\tds_read_b64_tr_b16 %3, %11\n\t"
                 "ds_read_b64_tr_b16 %4, %12\n\tds_read_b64_tr_b16 %5, %13\n\tds_read_b64_tr_b16 %6, %14\n\tds_read_b64_tr_b16 %7, %15\n\ts_waitcnt lgkmcnt(0)"
                 : "=&v"(r0), "=&v"(r1), "=&v"(r2), "=&v"(r3), "=&v"(r4), "=&v"(r5), "=&v"(r6), "=&v"(r7)
                 : "v"(a[0]), "v"(a[1]), "v"(a[2]), "v"(a[3]), "v"(a[4]), "v"(a[5]), "v"(a[6]), "v"(a[7]) : "memory");
    f[0] = cat8(r0, r1); f[1] = cat8(r2, r3); f[2] = cat8(r4, r5); f[3] = cat8(r6, r7);
}
DI void tr_frags4_nat(unsigned img, unsigned ks0, unsigned c, unsigned lane, bf16x8 (&f)[4]) {
    const unsigned h = lane >> 5; unsigned a[8];
#pragma unroll
    for (int s = 0; s < 4; ++s) { a[2 * s] = tr_addr(img, 16 * (ks0 + s) + 8 * h, c, lane); a[2 * s + 1] = tr_addr(img, 16 * (ks0 + s) + 8 * h + 4, c, lane); }
    tr_read8(a, f);
}
DI void tr_frags4_acc(unsigned img, unsigned c, unsigned lane, bf16x8 (&f)[4]) {
    const unsigned h = lane >> 5; unsigned a[8];
#pragma unroll
    for (int s = 0; s < 4; ++s) { a[2 * s] = tr_addr(img, 16 * s + 4 * h, c, lane); a[2 * s + 1] = tr_addr(img, 16 * s + 8 + 4 * h, c, lane); }
    tr_read8(a, f);
}
DI bf16x8 row_frag(LAS unsigned char* img, unsigned row, unsigned s, unsigned h) { return *(LAS bf16x8*)(img + off_b(row, 2 * s + h)); }

DI void load_tile64x256(LAS unsigned char* dst, const bf16_t* src, int ld) {
    const int tid = opaque_tid();
    u32x4 v[4];
#pragma unroll
    for (int i = 0; i < 4; ++i) { const int q = tid + 512 * i, row = q >> 5, cch = q & 31; v[i] = *(const u32x4*)(src + (size_t)row * ld + cch * 8); }
#pragma unroll
    for (int i = 0; i < 4; ++i) { const int q = tid + 512 * i, row = q >> 5, cch = q & 31; *(LAS u32x4*)(dst + (cch >> 4) * 16384 + off_b(row, cch & 15)) = v[i]; }
}

DI void ab_unit(LAS unsigned char* lds, int bh, int eb, const bf16_t* KD, const bf16_t* VR, bf16_t* Sprev, float* Sfinal) {
    const int tid = opaque_tid(), lane = tid & 63, w = __builtin_amdgcn_readfirstlane(tid >> 6), r = lane & 31, hh = lane >> 5;
    const int b = bh >> 2, h = launder_i(bh & 3);
    const float sdec = __builtin_amdgcn_exp2f(log2g_of(h) * 64.0f);
    const bf16_t* kd0 = KD + (size_t)(b * SEQ) * RW + h * 256;
    const bf16_t* v0 = VR + (size_t)(b * SEQ) * RW + h * 256 + (eb >> 2) * 128;
    u32x4 skX[4], svX[2], skY[4], svY[2];
#define AB_LOAD(sk, sv, c) do { _Pragma("unroll") for (int i = 0; i < 4; ++i) { const int q = tid + 512 * i, row = q >> 5, cch = q & 31; sk[i] = *(const u32x4*)(kd0 + (size_t)((c) * 64 + row) * RW + cch * 8); } \
        _Pragma("unroll") for (int i = 0; i < 2; ++i) { const int q = tid + 512 * i, row = q >> 4, cch = q & 15; sv[i] = *(const u32x4*)(v0 + (size_t)((c) * 64 + row) * RW + cch * 8); } } while (0)
#define AB_WRITE(sk, sv, bb) do { LAS unsigned char* d_ = lds + (bb) * 49152; \
        _Pragma("unroll") for (int i = 0; i < 4; ++i) { const int q = tid + 512 * i, row = q >> 5, cch = q & 31; *(LAS u32x4*)(d_ + (cch >> 4) * 16384 + off_b(row, cch & 15)) = sk[i]; } \
        _Pragma("unroll") for (int i = 0; i < 2; ++i) { const int q = tid + 512 * i, row = q >> 4, cch = q & 15; *(LAS u32x4*)(d_ + 32768 + off_b(row, cch)) = sv[i]; } } while (0)
    f32x16 acc; for (int i = 0; i < 16; ++i) acc[i] = 0.f;
    AB_LOAD(skX, svX, 0); AB_LOAD(skY, svY, 1); AB_WRITE(skX, svX, 0); AB_LOAD(skX, svX, 2);
    LDS_BARRIER();
    const unsigned lbase = (unsigned)(size_t)lds;
    bf16_t* sp = Sprev + (size_t)bh * 64 * 65536 + (size_t)(32 * w) * 256 + 32 * eb + r;
#define AB_STEP(c, skN, svN) do { \
        _Pragma("unroll") for (int i = 0; i < 16; ++i) sp[(size_t)(c) * 65536 + (size_t)crow(i, hh) * 256] = f2bf(acc[i]);     \
        const unsigned ib = lbase + ((c) & 1) * 49152; \
        bf16x8 af[4], bfr[4]; \
        tr_frags4_nat(ib + (w >> 2) * 16384, 0, w & 3, lane, af); tr_frags4_nat(ib + 32768, 0, eb & 3, lane, bfr); \
        _Pragma("unroll") for (int i = 0; i < 16; ++i) acc[i] *= sdec; \
        _Pragma("unroll") for (int s = 0; s < 4; ++s) acc = MFMA32(af[s], bfr[s], acc); \
        if ((c) + 1 < 64) { AB_WRITE(skN, svN, ((c) + 1) & 1); if ((c) + 3 < 64) AB_LOAD(skN, svN, (c) + 3); }     \
        LDS_BARRIER(); } while (0)
#pragma unroll 1
    for (int c = 0; c < 64; c += 2) { AB_STEP(c, skY, svY); AB_STEP(c + 1, skX, svX); }
#undef AB_STEP
    float* so = Sfinal + (size_t)bh * 65536 + (size_t)(32 * w) * 256 + 32 * eb + r;
#pragma unroll
    for (int i = 0; i < 16; ++i) so[(size_t)crow(i, hh) * 256] = acc[i];
#undef AB_LOAD
#undef AB_WRITE
}

template <bool SAMPLE>
DI void c_unit(LAS unsigned char* lds, int row0  , int h, const bf16_t* QR, const bf16_t* QD, const bf16_t* KR, const bf16_t* KD, const bf16_t* VR, const bf16_t* GR,
               const void* Sp_, float* Snew, bf16_t* MIXA) {
    const int tid = opaque_tid(), lane = tid & 63, w = __builtin_amdgcn_readfirstlane(tid >> 6), r = lane & 31, hh = lane >> 5;
    LAS unsigned char* R0 = lds; LAS unsigned char* R1 = lds + 32768; LAS unsigned char* R2 = lds + 65536; LAS unsigned char* R3 = lds + 98304;
    const unsigned lbase = (unsigned)(size_t)lds;
    const float l2g = log2g_of(launder_i(h));
    const size_t goff = (size_t)row0 * RW + h * 256;
    {
        const bf16_t* srcs[4] = {QR + goff, KR + goff, VR + goff, QD + goff};
        u32x4 v[4][4];
#pragma unroll
        for (int t = 0; t < 4; ++t)
#pragma unroll
            for (int i = 0; i < 4; ++i) { const int q = tid + 512 * i, row = q >> 5, cch = q & 31; v[t][i] = *(const u32x4*)(srcs[t] + (size_t)row * RW + cch * 8); }
#pragma unroll
        for (int t = 0; t < 4; ++t)
#pragma unroll
            for (int i = 0; i < 4; ++i) { const int q = tid + 512 * i, row = q >> 5, cch = q & 31; *(LAS u32x4*)(lds + t * 32768 + (cch >> 4) * 16384 + off_b(row, cch & 15)) = v[t][i]; }
    }
    LDS_BARRIER();
    u32x4 spv[8];
#define C_SPLOAD(dh_) do { const bf16_t* S0_ = (const bf16_t*)Sp_ + (size_t)((dh_) * 128) * 256; _Pragma("unroll") for (int i = 0; i < 8; ++i) { const int q = tid + 512 * i, d = q >> 5, cch = q & 31; spv[i] = *(const u32x4*)(S0_ + (size_t)d * 256 + cch * 8); } } while (0)
    if (!SAMPLE) C_SPLOAD(0);
    f32x16 o[2];
#pragma unroll
    for (int ib = 0; ib < 2; ++ib) {
        bf16x8 pf[2][2];
#pragma unroll
        for (int jb = 0; jb < 2; ++jb) {
            f32x16 x; for (int i = 0; i < 16; ++i) x[i] = 0.f;
#pragma unroll
            for (int s = 0; s < 16; ++s) x = MFMA32(row_frag(R1 + (s >> 3) * 16384, 32 * jb + r, s & 7, hh), row_frag(R0 + (s >> 3) * 16384, 32 * ib + r, s & 7, hh), x);
#pragma unroll
            for (int i = 0; i < 16; ++i) { const int dlt = (32 * ib + r) - (32 * jb + crow(i, hh)); x[i] *= __builtin_amdgcn_exp2f(l2g * (float)(dlt < 0 ? -dlt : dlt)); }
            pf[jb][0] = pack_step(x, 0); pf[jb][1] = pack_step(x, 1);
        }
        f32x16 a; for (int i = 0; i < 16; ++i) a[i] = 0.f;
        bf16x8 vf[4]; tr_frags4_acc(lbase + 65536 + (w >> 2) * 16384, w & 3, lane, vf);
#pragma unroll
        for (int jb = 0; jb < 2; ++jb)
#pragma unroll
            for (int s = 0; s < 2; ++s) a = MFMA32(pf[jb][s], vf[2 * jb + s], a);
        o[ib] = a;
    }
    LDS_BARRIER();
#pragma unroll 1
    for (int dh = 0; dh < 2; ++dh) {
        if (SAMPLE) {
            const float* S0 = (const float*)Sp_ + (size_t)(dh * 128) * 256;
#pragma unroll
            for (int bq = 0; bq < 2; ++bq) {
                f32x4 v[8];
#pragma unroll
                for (int i = 0; i < 4; ++i) { const int q = tid + 512 * (bq * 4 + i), d = q >> 5, cch = q & 31; v[2 * i] = *(const f32x4*)(S0 + (size_t)d * 256 + cch * 8); v[2 * i + 1] = *(const f32x4*)(S0 + (size_t)d * 256 + cch * 8 + 4); }
#pragma unroll
                for (int i = 0; i < 4; ++i) { const int q = tid + 512 * (bq * 4 + i), d = q >> 5, cch = q & 31; *(LAS u32x4*)(R0 + (cch >> 4) * 32768 + off_b(d, cch & 15)) = pack8f(v[2 * i], v[2 * i + 1]); }
            }
        } else {
#pragma unroll
            for (int i = 0; i < 8; ++i) { const int q = tid + 512 * i, d = q >> 5, cch = q & 31; *(LAS u32x4*)(R0 + (cch >> 4) * 32768 + off_b(d, cch & 15)) = spv[i]; }
            if (dh == 0) C_SPLOAD(1);
        }
        LDS_BARRIER();
#pragma unroll
        for (int s4 = 0; s4 < 2; ++s4) {
            bf16x8 bs[4]; tr_frags4_nat(lbase + (w >> 2) * 32768, 4 * s4, w & 3, lane, bs);
#pragma unroll
            for (int s = 0; s < 4; ++s)
#pragma unroll
                for (int ib = 0; ib < 2; ++ib) o[ib] = MFMA32(row_frag(R3 + dh * 16384, 32 * ib + r, 4 * s4 + s, hh), bs[s], o[ib]);
        }
        LDS_BARRIER();
    }
    u32x4 gq[4];
#pragma unroll
    for (int j = 0; j < 4; ++j) { const int c = tid + 512 * j, tok = c >> 5, ch = c & 31; gq[j] = *(const u32x4*)(GR + (size_t)(row0 + tok) * RW + h * 256 + ch * 8); }
    LAS float* red = (LAS float*)R0;
    LAS float* rsb = red + 512;
#pragma unroll
    for (int ib = 0; ib < 2; ++ib)
#pragma unroll
        for (int i = 0; i < 16; ++i) { float s = o[ib][i] * o[ib][i];
            s += shfl_xor_f(s, 1); s += shfl_xor_f(s, 2); s += shfl_xor_f(s, 4); s += shfl_xor_f(s, 8); s += shfl_xor_f(s, 16);
            if (r == 0) red[w * 64 + 32 * ib + crow(i, hh)] = s; }
    LDS_BARRIER();
    if (tid < 64) { float t = 0.f;
#pragma unroll
        for (int k = 0; k < 8; ++k) t += red[k * 64 + tid];
        rsb[tid] = __builtin_amdgcn_rsqf(t * (1.0f / 256.0f) + EPS); }
    LDS_BARRIER();
    {
        LAS unsigned char* OB = lds + 4096;
#pragma unroll
        for (int ib = 0; ib < 2; ++ib)
#pragma unroll
            for (int i = 0; i < 16; ++i) { const int tok = 32 * ib + crow(i, hh); *(LAS bf16_t*)(OB + tok * 528 + (32 * w + r) * 2) = f2bf(o[ib][i] * rsb[tok]); }
        LDS_BARRIER();
#pragma unroll
        for (int j = 0; j < 4; ++j) { const int c = tid + 512 * j, tok = c >> 5, ch = c & 31;
            f32x4 a0, a1, g0, g1; unpack8(*(LAS u32x4*)(OB + tok * 528 + ch * 16), a0, a1); unpack8(gq[j], g0, g1);
            *(u32x4*)(MIXA + (size_t)(row0 + tok) * DM + h * 256 + ch * 8) = pack8f(a0 * g0, a1 * g1); }
    }
    if (SAMPLE) {
        LDS_BARRIER();
        load_tile64x256(R0, KD + goff, RW);
        LDS_BARRIER();
        const float sdec = __builtin_amdgcn_exp2f(l2g * 64.0f);
        bf16x8 af[4]; tr_frags4_nat(lbase + (w >> 2) * 16384, 0, w & 3, lane, af);
        const float* S0 = (const float*)Sp_;
#pragma unroll 1
        for (int eb = 0; eb < 8; ++eb) {
            f32x16 a; for (int i = 0; i < 16; ++i) a[i] = 0.f;
            bf16x8 vf[4]; tr_frags4_nat(lbase + 65536 + (eb >> 2) * 16384, 0, eb & 3, lane, vf);
#pragma unroll
            for (int s = 0; s < 4; ++s) a = MFMA32(af[s], vf[s], a);
#pragma unroll
            for (int i = 0; i < 16; ++i) { const size_t ix = (size_t)(32 * w + crow(i, hh)) * 256 + 32 * eb + r; Snew[ix] = sdec * S0[ix] + a[i]; }
        }
    }
    LDS_BARRIER();
#undef C_SPLOAD
}
}
namespace fa {
template <class A, class Bt> struct same_t { static constexpr bool v = false; };
template <class A> struct same_t<A, A> { static constexpr bool v = true; };
constexpr int D = 128, LD = 1024, LDO = 2048;
constexpr bool WSKIP = false;
constexpr float THR = 8.f;
constexpr float SCALE = 0.08838834764831845f;
constexpr int NW = 8, QBLK = 32, KVBLK = 64, QB = NW * QBLK;
constexpr int SHM_V = KVBLK * D * 2, SHM_K = KVBLK * D * 2;
constexpr int OFF_BIAS = 2 * SHM_V + 2 * SHM_K + NW * 64 * 4;
constexpr int BIAS_MAX = 4096 + 64;
constexpr int LDS_BYTES = OFF_BIAS + BIAS_MAX * 4;
static_assert(LDS_BYTES <= LDS_MAIN, "attention LDS");
#define KSWZ(row, colB) ((row) * 256 + ((colB) ^ (((row) & 7) << 4)))
#define SBAR() __builtin_amdgcn_sched_barrier(0)
__device__ __forceinline__ int v_st(int k, int c) { const int kk = (k & ~0xC) | ((k & 4) << 1) | ((k & 8) >> 1); return ((kk >> 3) * 4 + (c >> 5)) * 512 + ((kk & 7) * 32 + (c & 31)) * 2; }
__device__ __forceinline__ int v_rd_base(int lane) { return ((lane & 3) << 3) | (((lane >> 2) & 3) << 6) | (((lane >> 4) & 1) << 5) | (((lane >> 5) & 1) << 8); }
constexpr int v_rd_off(int d0, int ks, int half) { return d0 * 512 + ks * 4096 + half * 2048; }
__device__ __forceinline__ int crow(int r, int hi) { return (r & 3) + 8 * (r >> 2) + 4 * hi; }
__device__ __forceinline__ unsigned cvtpk(float lo, float hi) {
    unsigned r; asm volatile("v_cvt_pk_bf16_f32 %0, %1, %2" : "=v"(r) : "v"(lo), "v"(hi)); return r;
}
__device__ __forceinline__ bf16x8 pack8(f32x4 a, f32x4 b) {
    u32x4 w = {cvtpk(a[0], a[1]), cvtpk(a[2], a[3]), cvtpk(b[0], b[1]), cvtpk(b[2], b[3])};
    return *reinterpret_cast<bf16x8*>(&w);
}
template <class T> __device__ __forceinline__ bf16x8 load8(const T* p) {
    if constexpr (same_t<T, float>::v) { return pack8(*(const f32x4*)p, *(const f32x4*)(p + 4)); }
    else { return *reinterpret_cast<const bf16x8*>(p); }
}
__device__ __forceinline__ void mask_tile(f32x16& p0, f32x16& p1, int dq, unsigned W) {
    const float NEG = -__builtin_inff();
#pragma unroll
    for (int r = 0; r < 16; ++r) {
        const int c = (r & 3) + 8 * (r >> 2);
        if ((unsigned)(dq - c) >= W) p0[r] = NEG;
        if ((unsigned)(dq - c - 32) >= W) p1[r] = NEG;
    }
}
__device__ __forceinline__ void partialSM(f32x16& p0, f32x16& p1, float& m_reg, float& mn, float& alpha) {
    float pmax = p0[0]; for (int r = 1; r < 16; ++r) pmax = fmaxf(pmax, p0[r]); for (int r = 0; r < 16; ++r) pmax = fmaxf(pmax, p1[r]);
    { auto rr = __builtin_amdgcn_permlane32_swap(__float_as_uint(pmax), __float_as_uint(pmax), false, false);
      pmax = fmaxf(__uint_as_float(rr[0]), __uint_as_float(rr[1])); }
    constexpr float C2 = 1.4426950408889634f * SCALE;
    if (__builtin_expect(__all((pmax - m_reg) * SCALE <= THR), 1)) { mn = m_reg; alpha = 1.f; }
    else { mn = fmaxf(m_reg, pmax); alpha = __builtin_amdgcn_exp2f((m_reg - mn) * C2); m_reg = mn; }
    const float mnL = -mn * C2;
    for (int r = 0; r < 16; ++r) p0[r] = fmaf(p0[r], C2, mnL); for (int r = 0; r < 16; ++r) p1[r] = fmaf(p1[r], C2, mnL);
    for (int r = 0; r < 16; ++r) p0[r] = __builtin_amdgcn_exp2f(p0[r]);
}
__device__ __forceinline__ void finishSM(f32x16& p0, f32x16& p1, float alpha, float& l_reg, bf16x8& pa0, bf16x8& pa1, bf16x8& pa2, bf16x8& pa3) {
    for (int r = 0; r < 16; ++r) p1[r] = __builtin_amdgcn_exp2f(p1[r]);
    float ps = 0; for (int r = 0; r < 16; ++r) ps += p0[r]; for (int r = 0; r < 16; ++r) ps += p1[r];
    { auto rr = __builtin_amdgcn_permlane32_swap(__float_as_uint(ps), __float_as_uint(ps), false, false);
      ps = __uint_as_float(rr[0]) + __uint_as_float(rr[1]); }
    l_reg = l_reg * alpha + ps;
#define PK4(P, B_, OUT) do { unsigned a0 = cvtpk(P[B_+0], P[B_+1]), a1 = cvtpk(P[B_+2], P[B_+3]);                          \
        unsigned b0 = cvtpk(P[B_+4], P[B_+5]), b1 = cvtpk(P[B_+6], P[B_+7]);                                             \
        auto r0 = __builtin_amdgcn_permlane32_swap(a0, b0, false, false); auto r1 = __builtin_amdgcn_permlane32_swap(a1, b1, false, false); \
        u32x4 w = {r0[0], r1[0], r0[1], r1[1]}; OUT = *reinterpret_cast<bf16x8*>(&w); } while (0)
    PK4(p0, 0, pa0); PK4(p0, 8, pa1); PK4(p1, 0, pa2); PK4(p1, 8, pa3);
#undef PK4
}
template <int KB, bool SK>
__device__ __forceinline__ void qkt(f32x16& p0, f32x16& p1, const char* K_lds, int r32, int hi, const bf16x8* qr, bool act, const float* bb) {
    if (SK && !act) { float NEG = -__builtin_inff(); asm volatile("" : "+v"(NEG));
#pragma unroll
        for (int r = 0; r < 16; ++r) { p0[r] = NEG; p1[r] = NEG; } return; }
    { const f32x4* b4 = (const f32x4*)(bb + 4 * hi);
#pragma unroll
      for (int g = 0; g < 4; ++g) { const f32x4 u0 = b4[2 * g], u1 = b4[8 + 2 * g];
          p0[4 * g] = u0[0]; p0[4 * g + 1] = u0[1]; p0[4 * g + 2] = u0[2]; p0[4 * g + 3] = u0[3];
          p1[4 * g] = u1[0]; p1[4 * g + 1] = u1[1]; p1[4 * g + 2] = u1[2]; p1[4 * g + 3] = u1[3]; } }
    const char* kb[4];
#pragma unroll
    for (int dd = 0; dd < 4; ++dd) kb[dd] = K_lds + KB * SHM_K + KSWZ(r32, (dd * 16 + hi * 8) * 2);
#pragma unroll
    for (int d0 = 0; d0 < 8; ++d0) { const char* a = kb[d0 & 3] + (d0 >> 2) * 128;
        bf16x8 b0 = *reinterpret_cast<const bf16x8*>(a);
        bf16x8 b1 = *reinterpret_cast<const bf16x8*>(a + 32 * 256);
        p0 = __builtin_amdgcn_mfma_f32_32x32x16_bf16(b0, qr[d0], p0, 0, 0, 0);
        p1 = __builtin_amdgcn_mfma_f32_32x32x16_bf16(b1, qr[d0], p1, 0, 0, 0); }
}
template <int VB, bool SK>
__device__ __forceinline__ void pv_tile(f32x16* o, int vb0, bf16x8 pa0, bf16x8 pa1, bf16x8 pa2, bf16x8 pa3, bool act) {
    if (SK && !act) return;
#define TRRD(dst, off) asm volatile("ds_read_b64_tr_b16 %0, %1 offset:%2" : "=&v"(dst) : "v"(vb0), "i"(off) : "memory")
#define PV_D0(d0) do { s16x4 l0, l1, l2, l3, h0, h1, h2, h3; constexpr int b_ = VB * SHM_V + v_rd_off(d0, 0, 0);     \
        TRRD(l0, b_); TRRD(h0, b_ + 2048); TRRD(l1, b_ + 4096); TRRD(h1, b_ + 6144); TRRD(l2, b_ + 8192); TRRD(h2, b_ + 10240); TRRD(l3, b_ + 12288); TRRD(h3, b_ + 14336); \
        asm volatile("s_waitcnt lgkmcnt(0)" ::: "memory"); SBAR();                 \
        o[d0] = __builtin_amdgcn_mfma_f32_32x32x16_bf16(pa0, (bf16x8){l0[0], l0[1], l0[2], l0[3], h0[0], h0[1], h0[2], h0[3]}, o[d0], 0, 0, 0);   \
        o[d0] = __builtin_amdgcn_mfma_f32_32x32x16_bf16(pa1, (bf16x8){l1[0], l1[1], l1[2], l1[3], h1[0], h1[1], h1[2], h1[3]}, o[d0], 0, 0, 0);   \
        o[d0] = __builtin_amdgcn_mfma_f32_32x32x16_bf16(pa2, (bf16x8){l2[0], l2[1], l2[2], l2[3], h2[0], h2[1], h2[2], h2[3]}, o[d0], 0, 0, 0);   \
        o[d0] = __builtin_amdgcn_mfma_f32_32x32x16_bf16(pa3, (bf16x8){l3[0], l3[1], l3[2], l3[3], h3[0], h3[1], h3[2], h3[3]}, o[d0], 0, 0, 0); } while (0)
    PV_D0(0); PV_D0(1); PV_D0(2); PV_D0(3);
#undef PV_D0
#undef TRRD
}

template <class TIn, class TOut> struct BlockRef { const TIn* Q; const TIn* K; const TIn* V; const TIn* K1; const TIn* V1; TOut* O; int P0, ksplit, nrows; };
template <class TIn> struct Seam {
    bf16x8 qr[8];
    bf16x8 st_v0, st_v1, st_k0, st_k1; f32x4 sf0, sf1, sf2, sf3;
    f32x4 tq[16];
};
__device__ __forceinline__ int swa_jlo(int P0, int W) { const int lowk = P0 - W + 1; return lowk > 0 ? lowk / KVBLK : 0; }
#define ROW(p, k0, rr) ((p) + (size_t)((k0) + (rr)) * LD + sc)
#define KSEL(k0) ((k0) >= cur.ksplit ? cur.K1 : cur.K)
#define VSEL(k0) ((k0) >= cur.ksplit ? cur.V1 : cur.V)
#define VMW() asm volatile("s_waitcnt vmcnt(0)" ::: "memory")
#define VMWN(n) asm volatile("s_waitcnt vmcnt(%0)" :: "i"(n) : "memory")
#define SLOAD_H(Kp, Vp, k0) do { S.st_v0 = load8<TIn>(ROW(Vp, k0, sr)); S.st_v1 = load8<TIn>(ROW(Vp, k0, 32 + sr));              \
                         S.st_k0 = load8<TIn>(ROW(Kp, k0, sr)); S.st_k1 = load8<TIn>(ROW(Kp, k0, 32 + sr)); } while (0)
#define SWRITE_HK(bf) do { *(bf16x8*)(K_lds + (bf) * SHM_K + kws) = S.st_k0; *(bf16x8*)(K_lds + (bf) * SHM_K + kws + 32 * 256) = S.st_k1; } while (0)
#define SWRITE_HV(bf) do { *(bf16x8*)(V_lds + (bf) * SHM_V + vst0) = S.st_v0; *(bf16x8*)(V_lds + (bf) * SHM_V + vst1) = S.st_v1; } while (0)
#define SWRITE_H(bf) do { SWRITE_HV(bf); SWRITE_HK(bf); } while (0)
#define SLOAD_F(p, k0) do { S.sf0 = *(const f32x4*)ROW(p, k0, sr); S.sf1 = *(const f32x4*)(ROW(p, k0, sr) + 4);                \
                            S.sf2 = *(const f32x4*)ROW(p, k0, 32 + sr); S.sf3 = *(const f32x4*)(ROW(p, k0, 32 + sr) + 4); } while (0)
#define SWRITE_KF(bf) do { *(bf16x8*)(K_lds + (bf) * SHM_K + kws) = pack8(S.sf0, S.sf1); *(bf16x8*)(K_lds + (bf) * SHM_K + kws + 32 * 256) = pack8(S.sf2, S.sf3); } while (0)
#define SWRITE_VF(bf) do { *(bf16x8*)(V_lds + (bf) * SHM_V + vst0) = pack8(S.sf0, S.sf1); *(bf16x8*)(V_lds + (bf) * SHM_V + vst1) = pack8(S.sf2, S.sf3); } while (0)
template <class TIn, class TOut>
__device__ __forceinline__ void causal_swa_prime(const BlockRef<TIn, TOut>& cur, int W, char* lds, Seam<TIn>& S) {
    constexpr bool F32 = same_t<TIn, float>::v;
    const int tid = opaque_tid(), wid = __builtin_amdgcn_readfirstlane(tid >> 6), lane = tid & 63, r32 = lane & 31, hi = lane >> 5;
    const int sr = tid >> 4, sc = (tid & 15) * 8, kws = KSWZ(sr, sc * 2); char* K_lds = lds + 2 * SHM_V;
    const int kb0 = swa_jlo(cur.P0, W) * KVBLK;
    for (int d0 = 0; d0 < 8; ++d0) S.qr[d0] = load8<TIn>(cur.Q + (size_t)(wid * QBLK + r32) * LD + d0 * 16 + hi * 8);
    if constexpr (F32) { SLOAD_F((const float*)cur.K, kb0); VMW(); SWRITE_KF(0); SBAR(); SLOAD_F((const float*)cur.V, kb0); }
    else { SLOAD_H(cur.K, cur.V, kb0); VMW(); SWRITE_HK(0); }
    __syncthreads();
}
template <class TIn, class TOut>
__device__ __forceinline__ void causal_swa_block(const BlockRef<TIn, TOut>& cur, const BlockRef<TIn, TOut>& nxt, int skv, int W, char* lds, Seam<TIn>& S) {
    constexpr bool F32 = same_t<TIn, float>::v;
    const int tid = opaque_tid(), wid = __builtin_amdgcn_readfirstlane(tid >> 6), lane = tid & 63, r32 = lane & 31, hi = lane >> 5;
    const int j_lo = swa_jlo(cur.P0, W);
    int j_hi = (cur.P0 + QB - 1) / KVBLK + 1; if (j_hi > skv / KVBLK) j_hi = skv / KVBLK;
    const int NT = j_hi - j_lo;
    const int kbn = swa_jlo(nxt.P0, W) * KVBLK;
    const int qlo = cur.P0 + wid * QBLK, qm = qlo + r32 - 4 * hi;
    char* V_lds = lds; char* K_lds = lds + 2 * SHM_V;
    float* ws = (float*)(lds + 2 * SHM_V + 2 * SHM_K) + wid * 64; float* li_l = ws, * al_l = ws + 32;
    float m_reg = -1e30f, l_reg = 0; f32x16 o[4] = {};
    const int sr = tid >> 4, sc = (tid & 15) * 8, vst0 = v_st(sr, sc), vst1 = v_st(32 + sr, sc), kws = KSWZ(sr, sc * 2);
    const int vb0 = (int)(uintptr_t)V_lds + v_rd_base(lane);
    const float* bl = (const float*)(lds + OFF_BIAS);
#define RESC(a) do { if (__any((a) < 1.f)) { if (hi == 0) al_l[r32] = (a); asm volatile("s_waitcnt lgkmcnt(0)" ::: "memory");              \
                     for (int d_ = 0; d_ < 4; ++d_) for (int r = 0; r < 16; ++r) o[d_][r] *= al_l[crow(r, hi)]; } } while (0)
#define KBASE(t) ((j_lo + (t)) * KVBLK)
#define ACT(t) (wvalid && KBASE(t) <= qlo + QBLK - 1 && KBASE(t) + KVBLK - 1 >= qlo - W + 1)
#define MASKT(P0_, P1_, t) do { const int kb_ = KBASE(t); if ((!SK || ACT(t)) && (kb_ + KVBLK - 1 > qlo || kb_ <= qlo + QBLK - 1 - W)) mask_tile(P0_, P1_, qm - kb_, (unsigned)W); } while (0)
    constexpr int NQL = F32 ? 16 : 8;
    constexpr bool SK = F32;
    const bool wvalid = wid * QBLK < cur.nrows;
#define WV (!SK || wvalid)
#define SEAM_K0() do { VMWN(NQL); if constexpr (F32) { SWRITE_KF(0); SBAR(); SLOAD_F((const float*)nxt.V, kbn); } else { SWRITE_HK(0); } SBAR(); } while (0)
    f32x16 pA0, pA1, pB0, pB1; float mnA, mnB, alA, alB; bf16x8 pa0, pa1, pa2, pa3;
    if constexpr (F32) { VMW(); SWRITE_VF(0); SBAR(); } else { SWRITE_HV(0); SBAR(); }
    if (NT > 1) { if constexpr (F32) SLOAD_F((const float*)KSEL(KBASE(1)), KBASE(1)); else SLOAD_H(KSEL(KBASE(1)), VSEL(KBASE(1)), KBASE(1)); }
    SBAR(); qkt<0, SK>(pA0, pA1, K_lds, r32, hi, S.qr, ACT(0), bl + KBASE(0));
    if constexpr (F32) { if (NT > 1) { VMW(); SWRITE_KF(1); SBAR(); SLOAD_F((const float*)VSEL(KBASE(1)), KBASE(1)); } }
    if (WV) { MASKT(pA0, pA1, 0); partialSM(pA0, pA1, m_reg, mnA, alA); }
    if (NT > 1) { VMW(); if constexpr (F32) { SWRITE_VF(1); SBAR(); if (NT > 2) SLOAD_F((const float*)KSEL(KBASE(2)), KBASE(2)); } else SWRITE_H(1); }
    __syncthreads();
#define HALF_STEP(PX0, PX1, mnX, alX, PY0, PY1, alY, t, KB, VB, SB) do {                                                      \
        SBAR(); qkt<KB, SK>(PX0, PX1, K_lds, r32, hi, S.qr, ACT(t), bl + KBASE(t));                                             \
        if (WV) finishSM(PY0, PY1, alY, l_reg, pa0, pa1, pa2, pa3); SBAR();                                                   \
        if ((t) + 1 < NT) { if constexpr (F32) { VMW(); SWRITE_KF(SB); SBAR(); SLOAD_F((const float*)VSEL(KBASE((t) + 1)), KBASE((t) + 1)); }  \
                            else { SLOAD_H(KSEL(KBASE((t) + 1)), VSEL(KBASE((t) + 1)), KBASE((t) + 1)); } SBAR(); }                                               \
        pv_tile<VB, SK>(o, vb0, pa0, pa1, pa2, pa3, ACT((t) - 1)); if (WV) { MASKT(PX0, PX1, (t)); partialSM(PX0, PX1, m_reg, mnX, alX); }                                        \
        __syncthreads();                                                                                                      \
        if ((t) + 1 < NT) { VMW(); if constexpr (F32) { SWRITE_VF(SB); SBAR(); if ((t) + 2 < NT) SLOAD_F((const float*)KSEL(KBASE((t) + 2)), KBASE((t) + 2)); } \
                            else { SWRITE_H(SB); } }                                                                          \
        if (WV) RESC(alX); __syncthreads(); } while (0)
    for (int t = 1; t + 1 < NT; t += 2) {
        HALF_STEP(pB0, pB1, mnB, alB, pA0, pA1, alA, t, 1, 0, 0);
        HALF_STEP(pA0, pA1, mnA, alA, pB0, pB1, alB, t + 1, 0, 1, 1);
    }
    const bool even = (NT & 1) == 0;
    if (even) { SBAR(); qkt<1, SK>(pB0, pB1, K_lds, r32, hi, S.qr, ACT(NT - 1), bl + KBASE(NT - 1)); SBAR(); }
    SBAR();
    if (WV) finishSM(pA0, pA1, alA, l_reg, pa0, pa1, pa2, pa3); SBAR();
    pv_tile<0, SK>(o, vb0, pa0, pa1, pa2, pa3, ACT(even ? NT - 2 : NT - 1));
    if (even) { if (WV) { MASKT(pB0, pB1, NT - 1); partialSM(pB0, pB1, m_reg, mnB, alB); } __syncthreads(); if (WV) { RESC(alB);
        finishSM(pB0, pB1, alB, l_reg, pa0, pa1, pa2, pa3); } SBAR(); pv_tile<1, SK>(o, vb0, pa0, pa1, pa2, pa3, ACT(NT - 1)); }
    SBAR();
    if (hi == 0) li_l[r32] = l_reg; asm volatile("s_waitcnt lgkmcnt(0)" ::: "memory");
    float rli[16];
#pragma unroll
    for (int r = 0; r < 16; ++r) rli[r] = __builtin_amdgcn_rcpf(li_l[crow(r, hi)]);
    TOut* Ow = cur.O + (size_t)(wid * QBLK) * LDO; if (wid * QBLK < cur.nrows) {
#pragma unroll
    for (int r = 0; r < 16; ++r) { const int orow = crow(r, hi);
#pragma unroll
        for (int d0 = 0; d0 < 4; ++d0) { const float v = o[d0][r] * rli[r];
            if constexpr (same_t<TOut, float>::v) { Ow[(size_t)orow * LDO + d0 * 32 + r32] = v; }
            else { const float vn = shfl_xor_f(v, 1);
                   if ((r32 & 1) == 0) *(unsigned*)(Ow + (size_t)orow * LDO + d0 * 32 + r32) = cvtpk(v, vn); } } } }
    __syncthreads();
#undef RESC
#undef WV
#undef KBASE
#undef ACT
#undef MASKT
#undef SEAM_K0
#undef HALF_STEP
}
#undef ROW
#undef KSEL
#undef VSEL
#undef VMW
#undef VMWN
#undef SLOAD_H
#undef SWRITE_HK
#undef SWRITE_HV
#undef SWRITE_H
#undef SLOAD_F
#undef SWRITE_KF
#undef SWRITE_VF
#undef KSWZ
#undef SBAR
}
DI void fox_bias(char* lds, const float* lf0, int n0, const float* lf1, int n1) {
    const int tid = opaque_tid(), lane = tid & 63, wave = tid >> 6, n = n0 + n1;
    float* bias = (float*)(lds + fa::OFF_BIAS);
    double* wt = (double*)(lds + 2 * fa::SHM_V + 2 * fa::SHM_K);
    double v[8]; double s = 0.0;
#pragma unroll
    for (int k = 0; k < 8; ++k) { const int t = 8 * tid + k; float x = 0.f; if (t < n0) x = lf0[(size_t)8 * t]; else if (t < n) x = lf1[(size_t)8 * (t - n0)]; s += (double)x; v[k] = s; }
    double inc = s;
#pragma unroll
    for (int o = 1; o < 64; o <<= 1) { const double y = shfl_up_d(inc, o); if (lane >= o) inc += y; }
    if (lane == 63) wt[wave] = inc;
    __syncthreads();
    double off = inc - s;
    for (int k = 0; k < wave; ++k) off += wt[k];
#pragma unroll
    for (int k = 0; k < 8; ++k) { const int t = 8 * tid + k; if (t < n) bias[t] = (float)(-(v[k] + off) * 11.313708498984761); }
    __syncthreads();
}

DI void pool_diff_phase(CP& P, int o, int layer, const u64* ss, const bf16_t* X) {
    const int tid = opaque_tid(), blk = blockIdx.x;
    bf16_t* DIFF = (bf16_t*)(P.ws + WS_MIXA);
    const int c0 = tid * 4, grp = c0 >> 9, w = 2 << grp;
    const f32x4 g = *(const f32x4*)(P.norm_mix + (size_t)layer * DM + c0);
#define XROW(m) ({ const u32x2 q_ = *(const u32x2*)(X + (size_t)(m) * DM + c0); (f32x4){__uint_as_float(q_.x << 16), __uint_as_float(q_.x & 0xffff0000u), __uint_as_float(q_.y << 16), __uint_as_float(q_.y & 0xffff0000u)}; })
    for (int st = blk; st < M / 32; st += NBLK) {
        const int m0 = st * 32; const bool prompt = m0 < MP;
        const int seq0 = prompt ? (m0 & ~(SEQ - 1)) : MP + ((m0 - MP) & ~(SSEQ - 1));
        const int T = prompt ? SEQ : SSEQ, b = prompt ? m0 / SEQ : (m0 - MP) / SSEQ;
        const float* sp = P.state_pool + ((size_t)o * NB_S + b) * PBUF * DM + c0;
        float* po = prompt ? P.out + O_PP + ((size_t)o * NB_P + b) * PBUF * DM + c0 : P.out + O_PS + ((size_t)o * NB_S + b) * PBUF * DM + c0;
#define HROW(m) ((m) >= seq0 ? (XROW(m) * (rs_of(ss, (m)) ) * g) : (prompt ? (f32x4){0.f, 0.f, 0.f, 0.f} : *(const f32x4*)(sp + (size_t)(PBUF + (m) - seq0) * DM)))
        f32x4 S = {0.f, 0.f, 0.f, 0.f};
        for (int k = 1; k < w; ++k) { const int m = m0 - k; S += HROW(m); }
        for (int t = m0; t < m0 + 32; ++t) {
            const f32x4 h = XROW(t) * rs_of(ss, t) * g;
            S += h;
            const int pos = t - seq0; const int cnt = prompt ? (pos + 1 < w ? pos + 1 : w) : w;
            const f32x4 d = S * (1.0f / (float)cnt) - h;
            u32x2 pk; pk.x = cvt_pk_bf16(d[0], d[1]); pk.y = cvt_pk_bf16(d[2], d[3]);
            *(u32x2*)(DIFF + (size_t)t * DM + c0) = pk;
            if (pos >= T - PBUF) *(f32x4*)(po + (size_t)(pos - (T - PBUF)) * DM) = h;
            const int mo = t - w + 1; S -= HROW(mo);
        }
#undef HROW
    }
#undef XROW
}

DI void final_norm_phase(CP& P, const u64* ss, const bf16_t* X) {
    const int tid = opaque_tid(), lane = tid & 63, wave = tid >> 6, blk = blockIdx.x;
    for (int m = blk * 8 + wave; m < M; m += NBLK * 8) {
        const float rs = rs_of(ss, m);
#pragma unroll
        for (int j = 0; j < 4; ++j) { const int c = j * 512 + lane * 8; f32x4 a, b; unpack8(*(const u32x4*)(X + (size_t)m * DM + c), a, b);
            *(f32x4*)(P.out + O_YP + (size_t)m * DM + c) = a * rs * *(const f32x4*)(P.final_norm + c);
            *(f32x4*)(P.out + O_YP + (size_t)m * DM + c + 4) = b * rs * *(const f32x4*)(P.final_norm + c + 4); }
    }
}

DI int dequeue(unsigned* head, volatile LAS unsigned* slot) {
    if (threadIdx.x == 0) *slot = __hip_atomic_fetch_add(head, 1u, __ATOMIC_RELAXED, __HIP_MEMORY_SCOPE_AGENT);
    LDS_BARRIER();
    const int v = (int)*slot;
    LDS_BARRIER();
    return v;
}

DI void warm_weights(const void* p, size_t bytes) {
    const size_t gt = (size_t)blockIdx.x * NTHR + opaque_tid();
    const char* b = (const char*)p;
    for (size_t o = gt * 16; o < bytes; o += (size_t)NBLK * NTHR * 16) { u32x4 d; asm volatile("global_load_dwordx4 %0, %1, off" : "=v"(d) : "v"(b + o) : "memory"); }
    asm volatile("s_waitcnt vmcnt(0)" ::: "memory");
}

template <int MODE>
DI void splitk_reduce(const pg8::StaticOrder& S, const EpiRes<MODE>& E) {
    const int tid = opaque_tid(), lane = tid & 63, wave = tid >> 6;
    const int nf = S.nfull(), nl = S.nwg - nf;
    for (int r = blockIdx.x * 8 + wave; r < nl * 256; r += gridDim.x * 8) {
        const int li = r >> 8, rl = r & 255;
        pg8::Unit u; S.tile_of(nf + li, u);
        const int row = u.pm * 256 + rl, col = u.pn * 256 + lane * 4;
        const float* sp = E.slab + (size_t)(li * 4) * 65536 + (size_t)rl * 256 + lane * 4;
        f32x4 v = (*(const f32x4*)sp + *(const f32x4*)(sp + 65536)) + (*(const f32x4*)(sp + 2 * 65536) + *(const f32x4*)(sp + 3 * 65536));
        const u32x2 xq = *(const u32x2*)(E.xold + (size_t)row * DM + col);
        f32x4 o = {__uint_as_float(xq.x << 16), __uint_as_float(xq.x & 0xffff0000u), __uint_as_float(xq.y << 16), __uint_as_float(xq.y & 0xffff0000u)};
        if (MODE == 1) { const float rs = rs_of(E.ss_in, row); const u32x2 q = *(const u32x2*)(E.pp + (size_t)row * DM + col);
            const f32x4 p = {__uint_as_float(q.x << 16), __uint_as_float(q.x & 0xffff0000u), __uint_as_float(q.y << 16), __uint_as_float(q.y & 0xffff0000u)};
#pragma unroll
            for (int j = 0; j < 4; ++j) v[j] = fsigm(v[j] * rs) * p[j]; }
        o += v;
        u32x2 pk; pk.x = cvt_pk_bf16(o[0], o[1]); pk.y = cvt_pk_bf16(o[2], o[3]);
        *(u32x2*)(E.xb + (size_t)row * DM + col) = pk;
        const float s = wave_sum((o[0] * o[0] + o[1] * o[1]) + (o[2] * o[2] + o[3] * o[3]));
        if (lane == 0) __hip_atomic_fetch_add(E.ssq_out + row, ss_fix(s), __ATOMIC_RELAXED, __HIP_MEMORY_SCOPE_AGENT);
    }
}

constexpr int PH_PRO = 0, PH_PP = 1, PH_L0 = 2, PH_PER_PAIR = 19, PH_FINAL = PH_L0 + 2 * PH_PER_PAIR, NPHASES = PH_FINAL + 1;

__global__ void __launch_bounds__(NTHR, 2) mk_fwd(Params Pv) {
    (void)Pv; CP* const kp = (CP*)__builtin_amdgcn_kernarg_segment_ptr();
#define P (*launder_cp(kp))
    extern __shared__ __attribute__((aligned(16))) unsigned char lds_raw[];
    LAS unsigned char* lds = (LAS unsigned char*)lds_raw;
    volatile LAS unsigned* MISC = (volatile LAS unsigned*)(lds + LDS_MISC);
    const int tid = opaque_tid(), blk = blockIdx.x, G = gridDim.x;
    unsigned* ctl = (unsigned*)(P.ws + WS_CTL);
    if (tid < 64) MISC[tid] = 0u;
    __syncthreads();
    XcdBarrier bar = xcd_barrier_post(ctl + CW_BAR, MISC + 8);
    const int lo = P.ph_lo, hi = P.ph_hi;
#ifndef DBG_MASK
#define DBG_MASK 0xffffffffu
#endif
#define IN(k) (lo <= (k) && (k) < hi)
#define INP(j) (((DBG_MASK >> (j)) & 1u) && IN(pb + (j)))
#define ING(k, bit) (((DBG_MASK >> (bit)) & 1u) && IN(k))
#ifndef PROBE_BAR2
#define PROBE_BAR2 0
#endif
#define SEAM(k) do { if (IN(k) && IN((k) + 1)) { xcd_barrier(bar); if (PROBE_BAR2) { xcd_barrier(bar); xcd_barrier(bar); } } } while (0)
#ifndef REP_MASK
#define REP_MASK 0u
#endif
#define NREP(bit) ((((REP_MASK) >> (bit)) & 1u) ? 2 : 1)
#ifndef E1_ROT
#define E1_ROT 17
#endif
#ifndef FILL_ON
#define FILL_ON 0
#endif
#ifndef FILL_GEMM
#define FILL_GEMM 0
#endif
#ifndef FILL_E2_FIRST
#define FILL_E2_FIRST 192
#endif
#ifndef FILL_BUDGET
#define FILL_BUDGET 10
#endif
#ifndef WARM_ON
#define WARM_ON 0
#endif
#ifndef PROBE_M0
#define PROBE_M0 0
#endif
#ifndef PROBE_NOMMA
#define PROBE_NOMMA 0
#endif
#ifndef SPLIT_O2
#define SPLIT_O2 2
#endif
#ifndef E3_MERGE
#define E3_MERGE 1
#endif
#ifndef SPLIT_F2
#define SPLIT_F2 1
#endif
#ifndef SPLIT_G1
#define SPLIT_G1 2
#endif
#ifndef SPLIT_TAIL
#define SPLIT_TAIL 1
#endif
#define REPEAT(bit) for (int rep = 0; rep < NREP(bit); ++rep, ((rep < NREP(bit)) ? xcd_barrier(bar) : (void)0))
#define DUMMY(bit) (rep + 1 < NREP(bit))

#define SS ((u64*)(P.ws + WS_SS))
#define XB0 ((bf16_t*)(P.ws + WS_XB0))
#define XB1 ((bf16_t*)(P.ws + WS_XB1))
#define MIXA ((bf16_t*)(P.ws + WS_MIXA))
#define ACT ((bf16_t*)(P.ws + WS_ACT))
#define QR ((bf16_t*)(P.ws + WS_QR))
#define QD ((bf16_t*)(P.ws + WS_QD))
#define KR ((bf16_t*)(P.ws + WS_KR))
#define KD ((bf16_t*)(P.ws + WS_KD))
#define VR ((bf16_t*)(P.ws + WS_VR))
#define GR ((bf16_t*)(P.ws + WS_GR))
#define QF ((bf16_t*)(P.ws + WS_QF))
#define KF ((bf16_t*)(P.ws + WS_KF))
#define VF ((bf16_t*)(P.ws + WS_VF))
#define QS32 ((float*)(P.ws + WS_QS32))
#define SPREV ((bf16_t*)(P.ws + WS_SPREV))

    if (ING(PH_PRO, 20)) REPEAT(20) { prologue(P, lds); }
    SEAM(PH_PRO);

#define RES_PHASES(J, MODE, SPL, AOP, LDA, BOP, LDB, KK, XOLD, XBO, SLOT_OUT, SLOT_IN, PPI, FILLB, DRAINL) \
    if (INP(J)) REPEAT(J) { \
        pg8::StaticOrder S; S.init(M, DM, launder_i(G), launder_i(blk), AOP, BOP, LDA, LDB, KK); S.split = (SPL); if (PROBE_NOMMA && DUMMY(J)) S.nomma = PROBE_NOMMA; \
        if (PROBE_M0 == 2 && DUMMY(J)) { EpiNull EN{(float*)(P.ws + WS_XDUM)}; pg8::gemm_phase<EpiNull, pg8::StaticOrder>(lds, pg8::Gemm{LDA, LDB, KK}, S, EN); } else \
        if (PROBE_M0 == 1 && MODE == 1 && DUMMY(J)) { EpiRes<0> E0{XOLD, (bf16_t*)(P.ws + WS_XBDUM), SS + (size_t)14 * M, SS, nullptr, (float*)(P.ws + WS_SLAB)}; \
            pg8::gemm_phase<EpiRes<0>, pg8::StaticOrder>(lds, pg8::Gemm{LDA, LDB, KK}, S, E0); } else { \
        EpiRes<MODE> E{XOLD, DUMMY(J) ? (bf16_t*)(P.ws + WS_XBDUM) : XBO, DUMMY(J) ? SS + (size_t)14 * M : SS + (size_t)(SLOT_OUT) * M, SS + (size_t)(SLOT_IN) * M, PPI, (SPL) == 2 ? nullptr : (float*)(P.ws + WS_SLAB)}; \
        pg8::gemm_phase<EpiRes<MODE>, pg8::StaticOrder, PG8_ALIGN, (SPL) == 2>(lds, pg8::Gemm{LDA, LDB, KK}, S, E); } \
        if (FILL_ON && FILL_GEMM && !(SPL) && blk >= 64) convert_fill(P, lds, ctl + CW_Q + 64 * 8, MISC + 17, NREST, FILLB);     \
        if (FILL_ON && (DRAINL) > 0) convert_fill(P, lds, ctl + CW_Q + 64 * 8, MISC + 17, (DRAINL), 1 << 30);       \
    } \
    SEAM(pb + (J)); \
    if (INP((J) + 1) && (SPL) == 1) { \
        pg8::StaticOrder S; S.init(M, DM, launder_i(G), launder_i(blk), AOP, BOP, LDA, LDB, KK); S.split = (SPL); \
        EpiRes<MODE> E{XOLD, XBO, SS + (size_t)(SLOT_OUT) * M, SS + (size_t)(SLOT_IN) * M, PPI, (float*)(P.ws + WS_SLAB)}; \
        splitk_reduce<MODE>(S, E); \
    } \
    if ((SPL) == 1) SEAM(pb + (J) + 1);
#define FFN_PLE_PHASES(J, XBA, XBB) \
    if (INP(J)) REPEAT(J) {     \
        pg8::StaticOrder S; S.init(M, 2 * DFF, launder_i(G), launder_i(blk), XBA, (const bf16_t*)(P.ws + WS_WGU) + (size_t)i * 2 * DFF * DM, DM, DM, DM); \
        if (PROBE_NOMMA && DUMMY(J)) S.nomma = PROBE_NOMMA; \
        EpiAct E{SS + (size_t)(3 * i + 1) * M, ACT}; \
        pg8::gemm_phase<EpiAct, pg8::StaticOrder>(lds, pg8::Gemm{DM, DM, DM}, S, E); \
    } \
    SEAM(pb + (J)); \
    RES_PHASES((J) + 1, 0, SPLIT_F2, ACT, LDF, (const bf16_t*)(P.ws + WS_WDN) + (size_t)i * DM * LDF, LDF, DFF, XBA, XBB, 3 * i + 2, 0, nullptr, 0, 0)     \
    RES_PHASES((J) + 3, 1, SPLIT_G1, XBB, DM, (const bf16_t*)(P.ws + WS_WPG) + (size_t)i * DM * DM, DM, DM, XBB, XBA, 3 * i + 3, 3 * i + 2, (const bf16_t*)(P.ws + WS_PPJ) + (size_t)i * M * DM, FILL_BUDGET, (i == 1) ? QL2 : (i == 2) ? NREST : 0)

#pragma unroll 1
    for (int lp = 0; lp < 2; ++lp) {
        const int pb = PH_L0 + lp * PH_PER_PAIR;
        {
            const int i = 2 * lp, e = lp;
#define oKs (P.out + O_KS + (size_t)e * MS * FW)
#define oVs (P.out + O_VS + (size_t)e * MS * FW)
            if (INP(0)) REPEAT(0) {
                pg8::StaticOrder S; S.init(M, INW_P, launder_i(G), launder_i(blk), XB0, (const bf16_t*)(P.ws + WS_WIN) + (size_t)e * INW_P * DM, DM, DM, DM);
                S.rot = E1_ROT;
                if (PROBE_M0 == 2 && DUMMY(0)) { EpiNull EN{(float*)(P.ws + WS_XDUM)}; pg8::gemm_phase<EpiNull, pg8::StaticOrder>(lds, pg8::Gemm{DM, DM, DM}, S, EN); } else {
                EpiIn E{P.ws, P.out, e, 3 * i};
                pg8::gemm_phase<EpiIn, pg8::StaticOrder>(lds, pg8::Gemm{DM, DM, DM}, S, E); }
                if (lp == 0 && ((DBG_MASK >> 21) & 1u) && blk >= 96) {
                    pg8::StaticOrder S2; S2.init(4 * M, DM, 160, launder_i(blk) - 96, (const bf16_t*)(P.ws + WS_PB), (const bf16_t*)(P.ws + WS_WPP), PLE, PLE, PLE); S2.b_mgrp = M / 256; S2.b_mrows = DM;
                    EpiBf E2{(bf16_t*)(P.ws + WS_PPJ), DM};
                    pg8::gemm_phase<EpiBf, pg8::StaticOrder>(lds, pg8::Gemm{PLE, PLE, PLE}, S2, E2);
                }
                if (i == 0) fgate_units<float>(P, lds, e, P.x_p, P.x_s, SS + (size_t)(3 * i) * M); else fgate_units<bf16_t>(P, lds, e, XB0, XB0 + (size_t)MP * DM, SS + (size_t)(3 * i) * M);
                if (FILL_ON && FILL_GEMM && lp == 1 && blk >= 96) convert_fill(P, lds, ctl + CW_Q + 64 * 8, MISC + 17, NREST, FILL_BUDGET);
            }
            SEAM(pb + 0);
            if (INP(1)) REPEAT(1) {
                if (FILL_ON && blk >= FILL_E2_FIRST) convert_fill(P, lds, ctl + CW_Q + 64 * 8, MISC + 17, lp == 0 ? QL2 : NREST, 1 << 30);
                unsigned* head = ctl + CW_Q + 64 * (e + 2 * rep);
                unsigned* dep = ctl + CW_DEP + 64 * 8 * (e + 2 * rep);
                for (;;) {
                    const int L = __builtin_amdgcn_readfirstlane(dequeue(head, MISC + 16));
                    if (L >= 64 + 512 + 128 + E3_MERGE * 512) break;
                    if (L < 64) { if ((DBG_MASK >> 24) & 1u) { rt::ab_unit(lds, L >> 3, L & 7, KD, VR, SPREV, P.out + O_RSP + (size_t)e * NB_P * HR * 65536);
                            if (E3_MERGE) { asm volatile("s_waitcnt vmcnt(0)" ::: "memory"); __syncthreads();
                                if (opaque_tid() == 0) { __builtin_amdgcn_fence(__ATOMIC_RELEASE, "agent"); asm volatile("s_waitcnt vmcnt(0)" ::: "memory"); (void)xb_add(dep + 64 * (L >> 3), 1u); } } }
                        continue; }
                    if (L >= 704) { if ((DBG_MASK >> 27) & 1u) { const int u = L - 704, bh = u >> 6, c = u & 63, b = bh >> 2, h = bh & 3;
                            if (opaque_tid() == 0) { XB_SPIN(xb_ld(dep + 64 * bh) < 8u, ctl + CW_BAR); __builtin_amdgcn_fence(__ATOMIC_ACQUIRE, "agent"); asm volatile("s_waitcnt vmcnt(0)" ::: "memory"); }
                            __syncthreads();
                            rt::c_unit<false>(lds, b * SEQ + c * 64, h, QR, QD, KR, KD, VR, GR, SPREV + ((size_t)bh * 64 + c) * 65536, nullptr, MIXA); }
                        continue; }
                    if (L >= 576) { if ((DBG_MASK >> 25) & 1u) { const int u = L - 576, b = u >> 2, h = u & 3; const size_t so = ((size_t)(e * NB_S + b) * HR + h) * 65536;
                        rt::c_unit<true>(lds, MP + b * SSEQ, h, QR, QD, KR, KD, VR, GR, P.state_ret + so, P.out + O_RSS + so, MIXA); } continue; }
                    if (!((DBG_MASK >> 26) & 1u)) continue;
                    const int Lq = L - 64;
                    const int QU = (Lq >= 32 && Lq < 288) ? Lq - 32 : -1, QP = Lq < 32 ? Lq : Lq - 256;
                    if (QU >= 0) {
                        const int u = QU, b = u >> 3, h = u & 7;
                        fox_bias((char*)lds_raw, P.cache_lf + ((size_t)(e * NB_S + b) * PAST) * HF + h, PAST, P.out + O_LS + ((size_t)e * MS + (size_t)b * SSEQ) * HF + h, SSEQ);
                        fa::BlockRef<float, bf16_t> cur;
                        cur.Q = QS32 + (size_t)b * SSEQ * FW + h * DHF;
                        cur.K = P.cache_k + ((size_t)(e * NB_S + b) * PAST) * FW + h * DHF; cur.V = P.cache_v + ((size_t)(e * NB_S + b) * PAST) * FW + h * DHF;
                        cur.K1 = oKs + (size_t)b * SSEQ * FW + h * DHF - (size_t)PAST * FW; cur.V1 = oVs + (size_t)b * SSEQ * FW + h * DHF - (size_t)PAST * FW;
                        cur.O = MIXA + ((size_t)MP + (size_t)b * SSEQ) * DM + RW + h * DHF; cur.P0 = PAST; cur.ksplit = PAST; cur.nrows = SSEQ;
                        fa::Seam<float> Sm;
                        fa::causal_swa_prime<float, bf16_t>(cur, 1 << 30, (char*)lds_raw, Sm);
                        fa::causal_swa_block<float, bf16_t>(cur, cur, PAST + SSEQ, 1 << 30, (char*)lds_raw, Sm);
                    } else {
                        const int Lp = QP;
                        const int qb = 15 - (Lp >> 4), bh = Lp & 15, b = bh >> 3, h = bh & 7;
                        fox_bias((char*)lds_raw, P.out + O_LP + ((size_t)e * MP + (size_t)b * SEQ) * HF + h, SEQ, nullptr, 0);
                        fa::BlockRef<bf16_t, bf16_t> cur;
                        cur.Q = QF + ((size_t)b * SEQ + (size_t)qb * 256) * FW + h * DHF; cur.K = KF + (size_t)b * SEQ * FW + h * DHF; cur.V = VF + (size_t)b * SEQ * FW + h * DHF;
                        cur.K1 = cur.K; cur.V1 = cur.V; cur.O = MIXA + ((size_t)b * SEQ + (size_t)qb * 256) * DM + RW + h * DHF; cur.P0 = qb * 256; cur.ksplit = 1 << 30; cur.nrows = 256;
                        fa::Seam<bf16_t> Sm;
                        fa::causal_swa_prime<bf16_t, bf16_t>(cur, 1 << 30, (char*)lds_raw, Sm);
                        fa::causal_swa_block<bf16_t, bf16_t>(cur, cur, SEQ, 1 << 30, (char*)lds_raw, Sm);
                    }
                }
            }
            SEAM(pb + 1);
            if (!E3_MERGE && INP(2)) REPEAT(2) {
                if ((DBG_MASK >> 27) & 1u) for (int u = blk; u < 512; u += G) { const int bh = u >> 6, c = u & 63, b = bh >> 2, h = bh & 3;
                    rt::c_unit<false>(lds, b * SEQ + c * 64, h, QR, QD, KR, KD, VR, GR, SPREV + ((size_t)bh * 64 + c) * 65536, nullptr, MIXA); }
            }
            if (!E3_MERGE) SEAM(pb + 2);
            RES_PHASES(3, 0, SPLIT_G1, MIXA, MIXW, (const bf16_t*)(P.ws + WS_WOUT) + (size_t)e * DM * MIXW, MIXW, MIXW, XB0, XB1, 3 * i + 1, 0, nullptr, FILL_BUDGET, (i == 2) ? QL3 : 0)
            FFN_PLE_PHASES(5, XB1, XB0)
        }
        {
            const int i = 2 * lp + 1, o = lp;
            if (INP(10)) REPEAT(10) pool_diff_phase(P, o, i, SS + (size_t)(3 * i) * M, XB1);
            SEAM(pb + 10);
            if (INP(11)) REPEAT(11) {
                pg8::StaticOrder S; S.init(M, DM, launder_i(G), launder_i(blk), MIXA, (const bf16_t*)(P.ws + WS_WPL) + (size_t)o * DM * 512, DM, 512, 512); S.a_kgrp = 512; S.a_kgrp_div = 2; S.split = SPLIT_O2;
                EpiRes<0> E{XB1, DUMMY(11) ? (bf16_t*)(P.ws + WS_XBDUM) : XB0, DUMMY(11) ? SS + (size_t)14 * M : SS + (size_t)(3 * i + 1) * M, nullptr, nullptr, nullptr};
                pg8::gemm_phase<EpiRes<0>, pg8::StaticOrder, PG8_ALIGN, SPLIT_O2 == 2>(lds, pg8::Gemm{DM, 512, 512}, S, E);
                if (FILL_ON && FILL_GEMM && blk >= 64) convert_fill(P, lds, ctl + CW_Q + 64 * 8, MISC + 17, NREST, FILL_BUDGET / 2);
                if (FILL_ON && i == 1) convert_fill(P, lds, ctl + CW_Q + 64 * 8, MISC + 17, QL1, 1 << 30);
            }
            SEAM(pb + 11);
            FFN_PLE_PHASES(12, XB0, XB1)
        }
    }
    if (ING(PH_FINAL, 22)) REPEAT(22) final_norm_phase(P, SS + (size_t)12 * M, XB0);
#undef RES_PHASES
#undef FFN_PLE_PHASES
#undef IN
#undef P
#undef SS
#undef XB0
#undef XB1
#undef MIXA
#undef ACT
#undef QR
#undef QD
#undef KR
#undef KD
#undef VR
#undef GR
#undef QF
#undef KF
#undef VF
#undef QS32
#undef SPREV
#undef oKs
#undef oVs
#undef INP
#undef ING
#undef SEAM
}

extern "C" void kernel_launch(void* const* d_in, const int* in_sizes, int n_in, void* d_out, int out_size, void* d_ws, size_t ws_size, hipStream_t stream) {
    static int ready = 0;
    if (ready == 0) {
        ready = -1;
        if (n_in != 23 || (size_t)out_size != O_END || ws_size < WS_END) { fprintf(stderr, "kernel_launch: unexpected shapes (n_in %d, out %d, ws %zu; need 23, %zu, >= %zu)\n", n_in, out_size, ws_size, (size_t)O_END, (size_t)WS_END); return; }
        if (hipFuncSetAttribute((const void*)mk_fwd, hipFuncAttributeMaxDynamicSharedMemorySize, LDS_BYTES) != hipSuccess) { fprintf(stderr, "kernel_launch: hipFuncSetAttribute failed\n"); return; }
        int dev = 0, cus = 0, per_cu = 0;
        if (hipGetDevice(&dev) != hipSuccess || hipDeviceGetAttribute(&cus, hipDeviceAttributeMultiprocessorCount, dev) != hipSuccess) { fprintf(stderr, "kernel_launch: device query failed\n"); return; }
        if (hipOccupancyMaxActiveBlocksPerMultiprocessor(&per_cu, (const void*)mk_fwd, NTHR, LDS_BYTES) != hipSuccess || per_cu < 1) { fprintf(stderr, "kernel_launch: occupancy query says %d blocks per CU\n", per_cu); (void)hipGetLastError(); }
        if (cus < NBLK) { fprintf(stderr, "kernel_launch: %d CUs < %d workgroups: the grid would not be resident\n", cus, NBLK); return; }
        ready = 1;
    }
    if (ready < 0) return;
    if (hipMemsetAsync((char*)d_ws + WS_CTL, 0, ZERO_BYTES, stream) != hipSuccess) { fprintf(stderr, "kernel_launch: memset failed\n"); return; }
    Params p{};
    const float** f = (const float**)&p;
    for (int i = 0; i < 23; ++i) f[i] = (const float*)d_in[i];
    p.out = (float*)d_out; p.ws = (unsigned char*)d_ws;
#if MK_MULTI
    for (int ph = 0; ph < NPHASES; ++ph) { p.ph_lo = ph; p.ph_hi = ph + 1; hipLaunchKernelGGL(mk_fwd, dim3(NBLK), dim3(NTHR), LDS_BYTES, stream, p); }
#else
    p.ph_lo = 0; p.ph_hi = NPHASES;
    hipLaunchKernelGGL(mk_fwd, dim3(NBLK), dim3(NTHR), LDS_BYTES, stream, p);
#endif
    const hipError_t le = hipPeekAtLastError();
    if (le != hipSuccess) fprintf(stderr, "kernel_launch: launch failed: %s\n", hipGetErrorName(le));
}
```
